# Optimizing an MI355X kernel written in HIP

```python
import jax
import jax.numpy as jnp
from jax import lax
import numpy as np


D_MODEL = 2048
BATCH = 4
SEQ = 2048
DEPTH = 1

CTX_LEN = 256
GRID_W = 64
CHUNK = 64
RET_HEADS = 8
RET_DK = 256
RET_DV = 256
GLA_HEADS = 4
GLA_DK = 256
GLA_DV = 512
GLA_RANK = 16
GLA_TAU = 16.0
D_FF = ((8 * D_MODEL // 3 + 127) // 128) * 128
CONV_K = 3
ROPE_BASE = 10000.0
EPS = 1e-6
RET_QK = RET_HEADS * RET_DK
RET_V = RET_HEADS * RET_DV
GLA_QK = GLA_HEADS * GLA_DK
GLA_V = GLA_HEADS * GLA_DV
SPLIT_SIZES = (RET_QK, RET_QK, RET_V, RET_V, GLA_QK, GLA_QK, GLA_V, GLA_V, GLA_RANK, GLA_RANK, D_MODEL, D_MODEL)
N_IN = 2 * RET_QK + 2 * RET_V + 2 * GLA_QK + 2 * GLA_V + 2 * GLA_RANK + 2 * D_MODEL

kernel_name = 'hybrid_retention_gla_convffn_block'


def rmsnorm(t, g):
    tf = t.astype(jnp.float32)
    y = tf * lax.rsqrt(jnp.mean(tf * tf, axis=-1, keepdims=True) + EPS)
    return y.astype(t.dtype) * g


def split_cols(p):
    bounds = []
    s = 0
    for n in SPLIT_SIZES[:-1]:
        s += n
        bounds.append(s)
    return jnp.split(p, bounds, axis=-1)


def to_heads(t, n_heads):
    b, l, _ = t.shape
    return t.reshape(b, l, n_heads, -1).transpose(0, 2, 1, 3)


def from_heads(t):
    b, h, l, d = t.shape
    return t.transpose(0, 2, 1, 3).reshape(b, l, h * d)


def to_chunks(t):
    b, h, l, d = t.shape
    return t.reshape(b, h, l // CHUNK, CHUNK, d).transpose(2, 0, 1, 3, 4)


def from_chunks(t):
    n, b, h, c, d = t.shape
    return t.transpose(1, 2, 0, 3, 4).reshape(b, h, n * c, d)


def flip(t):
    return jnp.flip(t, axis=2)


def rope_2d(t):
    l = t.shape[2]
    pos = jnp.arange(l)
    row = (pos // GRID_W).astype(jnp.float32)
    col = (pos % GRID_W).astype(jnp.float32)
    n_freq = t.shape[-1] // 4
    inv = ROPE_BASE ** (-jnp.arange(n_freq, dtype=jnp.float32) / n_freq)
    ang = jnp.concatenate([row[:, None] * inv, col[:, None] * inv], axis=-1)
    cos = jnp.concatenate([jnp.cos(ang), jnp.cos(ang)], axis=-1).astype(t.dtype)
    sin = jnp.concatenate([jnp.sin(ang), jnp.sin(ang)], axis=-1).astype(t.dtype)
    t1, t2 = jnp.split(t, 2, axis=-1)
    return t * cos + jnp.concatenate([-t2, t1], axis=-1) * sin


def retention_scan(q, k, v, log_g, s0):
    idx = jnp.arange(CHUNK, dtype=jnp.float32)
    mask = idx[:, None] >= idx[None, :]
    dmat = jnp.exp(jnp.where(mask[None], (idx[:, None] - idx[None, :])[None] * log_g[:, None, None], -jnp.inf))
    q_dec = jnp.exp((idx + 1.0)[None, :] * log_g[:, None])[None, :, :, None]
    k_dec = jnp.exp((CHUNK - 1.0 - idx)[None, :] * log_g[:, None])[None, :, :, None]
    c_dec = jnp.exp(CHUNK * log_g)[None, :, None, None]

    def step(s, xs):
        qc, kc, vc = xs
        inter = jnp.einsum('bhcd,bhde->bhce', qc * q_dec, s)
        scores = jnp.einsum('bhnd,bhmd->bhnm', qc, kc) * dmat[None]
        intra = jnp.einsum('bhnm,bhme->bhne', scores, vc)
        s_new = s * c_dec + jnp.einsum('bhcd,bhce->bhde', kc * k_dec, vc)
        return s_new, inter + intra

    s_fin, o = lax.scan(step, s0, (to_chunks(q), to_chunks(k), to_chunks(v)))
    return from_chunks(o), s_fin


def gla_scan(q, k, v, log_a, s0):
    idx = jnp.arange(CHUNK)
    mask = (idx[:, None] >= idx[None, :])[:, :, None]

    def step(s, xs):
        qc, kc, vc, ac = xs
        b = jnp.cumsum(ac, axis=-2)
        inter = jnp.einsum('bhcd,bhde->bhce', qc * jnp.exp(b), s)
        diff = b[:, :, :, None, :] - b[:, :, None, :, :]
        decay = jnp.exp(jnp.where(mask, diff, -jnp.inf))
        scores = jnp.einsum('bhnd,bhmd,bhnmd->bhnm', qc, kc, decay)
        intra = jnp.einsum('bhnm,bhme->bhne', scores, vc)
        b_last = b[:, :, -1:, :]
        s_new = jnp.exp(b_last[:, :, 0, :])[..., None] * s + jnp.einsum('bhcd,bhce->bhde', kc * jnp.exp(b_last - b), vc)
        return s_new, inter + intra

    s_fin, o = lax.scan(step, s0, (to_chunks(q), to_chunks(k), to_chunks(v), to_chunks(log_a)))
    return from_chunks(o), s_fin


def retention_readout(o, gate, g):
    mu = jnp.mean(o, axis=-1, keepdims=True)
    var = jnp.mean(jnp.square(o - mu), axis=-1, keepdims=True)
    n = from_heads((o - mu) * lax.rsqrt(var + EPS)).astype(gate.dtype)
    return n * g * jax.nn.silu(gate)


def gla_readout(o, gate, g):
    n = from_heads(o * lax.rsqrt(jnp.mean(o * o, axis=-1, keepdims=True) + EPS)).astype(gate.dtype)
    return n * g * jax.nn.silu(gate)


def token_mixer(h, hc, w_in, decay_logit, gate_up, gate_bias, ret_g, gla_g, w_rp, w_gp, w_o, want_ctx):
    bsz = h.shape[0]
    log_gamma = jax.nn.log_sigmoid(decay_logit.astype(jnp.float32))

    def prepare(p, latent):
        rq, rk, rv, rg, gq, gk, gv, gg, gaf, gab, mr, mg = split_cols(p)
        rq = to_heads(rq, RET_HEADS)
        rk = to_heads(rk, RET_HEADS) * RET_DK ** -0.5
        if latent:
            rq = rope_2d(rq)
            rk = rope_2d(rk)
        la_f = to_heads(jax.nn.log_sigmoid((gaf @ gate_up[0] + gate_bias[0]).astype(jnp.float32)) / GLA_TAU, GLA_HEADS)
        la_b = to_heads(jax.nn.log_sigmoid((gab @ gate_up[1] + gate_bias[1]).astype(jnp.float32)) / GLA_TAU, GLA_HEADS)
        return (rq, rk, to_heads(rv, RET_HEADS), rg, to_heads(gq, GLA_HEADS),
                to_heads(gk, GLA_HEADS) * GLA_DK ** -0.5, to_heads(gv, GLA_HEADS), gg, la_f, la_b, mr, mg)

    rq_l, rk_l, rv_l, rg_l, gq_l, gk_l, gv_l, gg_l, af_l, ab_l, mr_l, mg_l = prepare(h @ w_in, True)
    rq_c, rk_c, rv_c, rg_c, gq_c, gk_c, gv_c, gg_c, af_c, ab_c, mr_c, mg_c = prepare(hc @ w_in, False)
    s0_ret = jnp.zeros((bsz, RET_HEADS, RET_DK, RET_DV), jnp.float32)
    s0_gla = jnp.zeros((bsz, GLA_HEADS, GLA_DK, GLA_DV), jnp.float32)

    ro_cf, s_rf = retention_scan(rq_c, rk_c, rv_c, log_gamma[0], s0_ret)
    ro_cb, s_rb = retention_scan(flip(rq_c), flip(rk_c), flip(rv_c), log_gamma[1], s0_ret)
    ro_l = (retention_scan(rq_l, rk_l, rv_l, log_gamma[0], s_rf)[0]
            + flip(retention_scan(flip(rq_l), flip(rk_l), flip(rv_l), log_gamma[1], s_rb)[0]))

    go_cf, s_gf = gla_scan(gq_c, gk_c, gv_c, af_c, s0_gla)
    go_cb, s_gb = gla_scan(flip(gq_c), flip(gk_c), flip(gv_c), flip(ab_c), s0_gla)
    go_l = (gla_scan(gq_l, gk_l, gv_l, af_l, s_gf)[0]
            + flip(gla_scan(flip(gq_l), flip(gk_l), flip(gv_l), flip(ab_l), s_gb)[0]))

    def merge(ro, rg, go, gg, mr, mg):
        y_r = retention_readout(ro, rg, ret_g) @ w_rp
        y_g = gla_readout(go, gg, gla_g) @ w_gp
        return (jax.nn.sigmoid(mr) * y_r + jax.nn.sigmoid(mg) * y_g) @ w_o

    y = merge(ro_l, rg_l, go_l, gg_l, mr_l, mg_l)
    yc = merge(ro_cf + flip(ro_cb), rg_c, go_cf + flip(go_cb), gg_c, mr_c, mg_c) if want_ctx else None
    return y, yc


def conv_ffn(h, w_up, conv_w, conv_b, w_down, rows, cols):
    bsz, l, _ = h.shape
    a, v = jnp.split(h @ w_up, 2, axis=-1)
    a = a.reshape(bsz, rows, cols, D_FF)
    a = lax.conv_general_dilated(a, conv_w[:, :, None, :], window_strides=(1, 1), padding='SAME',
                                 dimension_numbers=('NHWC', 'HWIO', 'NHWC'), feature_group_count=D_FF)
    a = jax.nn.gelu(a.reshape(bsz, l, D_FF) + conv_b)
    return (a * v) @ w_down


def setup_inputs(seed: int = 0) -> dict:
    key = jax.random.key(seed)
    ks = jax.random.split(key, 24)

    def nrm(k, shape, s):
        return jax.random.normal(k, shape, jnp.float32) * s

    ret_init = jnp.log(2.0 ** jnp.arange(5, 5 + RET_HEADS, dtype=jnp.float32) - 1.0)
    return {
        'x': nrm(ks[0], (BATCH, SEQ, D_MODEL), 1.0),
        'c': nrm(ks[1], (BATCH, D_MODEL), 1.0),
        'ctx': nrm(ks[2], (BATCH, CTX_LEN, D_MODEL), 1.0),
        'c_ctx': nrm(ks[3], (D_MODEL,), 1.0),
        'w_ada': nrm(ks[4], (DEPTH, D_MODEL, 6 * D_MODEL), D_MODEL ** -0.5),
        'b_ada': nrm(ks[5], (DEPTH, 6 * D_MODEL), 0.01),
        'norm1_g': 1.0 + nrm(ks[6], (DEPTH, D_MODEL), 0.02),
        'w_in': nrm(ks[7], (DEPTH, D_MODEL, N_IN), D_MODEL ** -0.5),
        'ret_decay_logit': ret_init[None, None, :] + nrm(ks[8], (DEPTH, 2, RET_HEADS), 0.01),
        'gla_gate_up': nrm(ks[9], (DEPTH, 2, GLA_RANK, GLA_QK), GLA_RANK ** -0.5),
        'gla_gate_bias': nrm(ks[10], (DEPTH, 2, GLA_QK), 0.1),
        'ret_norm_g': 1.0 + nrm(ks[11], (DEPTH, RET_V), 0.02),
        'gla_norm_g': 1.0 + nrm(ks[12], (DEPTH, GLA_V), 0.02),
        'w_ret_proj': nrm(ks[13], (DEPTH, RET_V, D_MODEL), RET_V ** -0.5),
        'w_gla_proj': nrm(ks[14], (DEPTH, GLA_V, D_MODEL), GLA_V ** -0.5),
        'w_out': nrm(ks[15], (DEPTH, D_MODEL, D_MODEL), D_MODEL ** -0.5),
        'norm2_g': 1.0 + nrm(ks[16], (DEPTH, D_MODEL), 0.02),
        'w_up': nrm(ks[17], (DEPTH, D_MODEL, 2 * D_FF), D_MODEL ** -0.5),
        'conv_w': nrm(ks[18], (DEPTH, CONV_K, CONV_K, D_FF), 1.0 / CONV_K),
        'conv_b': nrm(ks[19], (DEPTH, D_FF), 0.01),
        'w_down': nrm(ks[20], (DEPTH, D_FF, D_MODEL), D_FF ** -0.5),
        'final_g': 1.0 + nrm(ks[21], (D_MODEL,), 0.02),
    }


def reference(x, c, ctx, c_ctx, w_ada, b_ada, norm1_g, w_in, ret_decay_logit, gla_gate_up, gla_gate_bias,
              ret_norm_g, gla_norm_g, w_ret_proj, w_gla_proj, w_out, norm2_g, w_up, conv_w, conv_b, w_down, final_g):
    rows = x.shape[1] // GRID_W
    ctx_len = ctx.shape[1]
    for l in range(DEPTH):
        last = l == DEPTH - 1
        mod = (jax.nn.silu(c) @ w_ada[l] + b_ada[l])[:, None, :]
        mod_c = jax.nn.silu(c_ctx) @ w_ada[l] + b_ada[l]
        sh1, sc1, g1, sh2, sc2, g2 = jnp.split(mod, 6, axis=-1)
        csh1, csc1, cg1, csh2, csc2, cg2 = jnp.split(mod_c, 6, axis=-1)

        h = rmsnorm(x, norm1_g[l]) * (1.0 + sc1) + sh1
        hc = rmsnorm(ctx, norm1_g[l]) * (1.0 + csc1) + csh1
        y, yc = token_mixer(h, hc, w_in[l], ret_decay_logit[l], gla_gate_up[l], gla_gate_bias[l],
                            ret_norm_g[l], gla_norm_g[l], w_ret_proj[l], w_gla_proj[l], w_out[l], not last)
        x = x + g1 * y

        h = rmsnorm(x, norm2_g[l]) * (1.0 + sc2) + sh2
        x = x + g2 * conv_ffn(h, w_up[l], conv_w[l], conv_b[l], w_down[l], rows, GRID_W)

        if not last:
            ctx = ctx + cg1 * yc
            hc = rmsnorm(ctx, norm2_g[l]) * (1.0 + csc2) + csh2
            ctx = ctx + cg2 * conv_ffn(hc, w_up[l], conv_w[l], conv_b[l], w_down[l], 1, ctx_len)
    return rmsnorm(x, final_g)
```

```cpp
#include <hip/hip_runtime.h>
#include <hip/hip_bf16.h>
#include <hip/hip_cooperative_groups.h>
#include <cstdio>
namespace cg = cooperative_groups;
namespace pg8 {
#define PG8_LAS __attribute__((address_space(3)))
typedef unsigned short bf16_t;
typedef short bf16x8 __attribute__((ext_vector_type(8)));
typedef float f32x4 __attribute__((ext_vector_type(4)));
typedef unsigned u32x4 __attribute__((ext_vector_type(4)));
constexpr int BM = 256, BK = 64, HALF = 128, HTB = HALF * BK * 2  , STAGE_BYTES = 8 * HTB, NXCD = 8, WGM = 8;

__host__ __device__ __forceinline__ int lds_byte(int r, int c) { const int st = (r >> 4) * 2 + (c >> 5), rr = r & 15, cc = c & 31, ob = rr * 64 + cc * 2; return st * 1024 + (ob ^ (((ob >> 9) & 1) << 5)); }
__host__ __device__ __forceinline__ void stage_rc(int b, int& R, int& C) { const int st = b / 1024, sb = b % 1024, swz = sb ^ (((sb >> 9) & 1) << 5); R = (st >> 1) * 16 + swz / 64; C = (st & 1) * 32 + (swz % 64) / 2; }
__host__ __device__ __forceinline__ int perm32(int rho) { const int n = rho >> 4, i = rho & 15; return 8 * (i >> 2) + 4 * n + (i & 3); }

struct Unit { int pm, pn; };
struct Gemm { const bf16_t* A; const bf16_t* Bt; int M, N, K; };

struct StaticOrder {
    int nM, nN, nwg, G, c;
    __host__ __device__ void init(int M, int N, int G_, int c_) { nM = M / BM; nN = N / BM; nwg = nM * nN; G = G_; c = c_; }
    __host__ __device__ bool next(int i, Unit& u) const {
        const long L = (long)i * G + c; if (L >= nwg) return false;
        int wgid = (int)L; { const int q = nwg / NXCD, r = nwg % NXCD, xcd = wgid % NXCD, off = wgid / NXCD; wgid = (xcd < r ? xcd * (q + 1) : r * (q + 1) + (xcd - r) * q) + off; }
        const int nig = WGM * nN, gid = wgid / nig, fm = gid * WGM, gsz = (nM - fm) < WGM ? (nM - fm) : WGM;
        u.pm = fm + ((wgid % nig) % gsz); u.pn = (wgid % nig) / gsz; return true;
    }
    __device__ __forceinline__ void a_ready(const Unit&) const {}
    __device__ __forceinline__ void done(const Unit&) const {}
};
__device__ __forceinline__ unsigned cvt_pk_bf16(float lo, float hi) { unsigned r; asm volatile("v_cvt_pk_bf16_f32 %0, %1, %2" : "=v"(r) : "v"(lo), "v"(hi)); return r; }
typedef float f32x2 __attribute__((ext_vector_type(2)));
__device__ __forceinline__ f32x2 gelu_pk(f32x2 v) {
    const f32x2 av = __builtin_elementwise_abs(v), d = av * 0.2316418882f + 1.0f;
    f32x2 t; t.x = __builtin_amdgcn_rcpf(d.x); t.y = __builtin_amdgcn_rcpf(d.y);
    f32x2 q = t * 0.5307027145f + (-0.7265760135f); q = q * t + 0.7107068705f; q = q * t + (-0.142248368f); q = q * t + 0.127414796f; q = q * t;
    const f32x2 s = (v * v) * (-0.72134752044f);
    f32x2 e; e.x = __builtin_amdgcn_exp2f(s.x); e.y = __builtin_amdgcn_exp2f(s.y);
    const f32x2 m = v * (q * e), r = v - m;
    f32x2 o; o.x = v.x < 0.f ? m.x : r.x; o.y = v.y < 0.f ? m.y : r.y; return o;
}
template <class Epi, class Sched, bool STAMP = false>
__device__ __forceinline__ void gemm_phase(PG8_LAS unsigned char* lds, const Gemm g, const Sched& S, const Epi& E, unsigned long long* stamps) {
    const int tid = threadIdx.x, wid = __builtin_amdgcn_readfirstlane(tid >> 6), lane = tid & 63, wr = wid >> 2, wc = wid & 3, fr = lane & 15, fq = lane >> 4;
    const int K = g.K, nt = K / BK;
    int ts_lo = 0, ts_hi = 0, nts = 0; const unsigned long long rt_entry = STAMP ? (unsigned long long)wall_clock64() : 0ull;
#define PG8_STAMP() do { if (STAMP && wid == 0 && nts < 64) { const unsigned long long _c = (unsigned long long)clock64(); \
        ts_lo = (lane == nts) ? (int)(unsigned)_c : ts_lo; ts_hi = (lane == nts) ? (int)(unsigned)(_c >> 32) : ts_hi; ++nts; } } while (0)
    PG8_STAMP();
    unsigned voffA[2], voffB[2];
#pragma unroll
    for (int i = 0; i < 2; ++i) { int R, C; stage_rc(tid * 16 + i * 8192, R, C); const int Rb = Epi::PERM ? ((R & ~31) + perm32(R & 31)) : R;
        voffA[i] = (unsigned)(R * K + C) * 2u; voffB[i] = (unsigned)(Rb * K + C) * 2u; }
    const size_t kstep = (size_t)(BK * 2);
    const size_t hstep = (size_t)HALF * K * 2;
    const size_t tstep = 2 * hstep;
    const unsigned ldsw = (unsigned)wid * 1024u;
    const int aoff = lds_byte(wr * 64 + fr, fq * 8), boff = lds_byte(wc * 32 + fr, fq * 8);
#define PG8_SA(b, h) (((b) * 2 + (h)) * HTB)
#define PG8_SB(b, h) ((4 + (b) * 2 + (h)) * HTB)
#define PG8_STAGE(bufoff, gbase, voff) do { _Pragma("unroll") for (int _i = 0; _i < 2; ++_i) \
        __builtin_amdgcn_global_load_lds((const unsigned*)((const char*)(gbase) + (voff)[_i]), (PG8_LAS unsigned*)(lds + (bufoff) + ldsw + _i * 8192), 16, 0, 0); } while (0)
#define PG8_LDA(dst, b, h) do { _Pragma("unroll") for (int m = 0; m < 4; ++m) _Pragma("unroll") for (int k = 0; k < 2; ++k) dst[m][k] = *(const PG8_LAS bf16x8*)(lds + PG8_SA(b, h) + aoff + m * 2048 + k * 1024); } while (0)
#define PG8_LDB(dst, b, h) do { _Pragma("unroll") for (int n = 0; n < 2; ++n) _Pragma("unroll") for (int k = 0; k < 2; ++k) dst[n][k] = *(const PG8_LAS bf16x8*)(lds + PG8_SB(b, h) + boff + n * 2048 + k * 1024); } while (0)
#define PG8_MMA(ai, bj, At, Bt) do { __builtin_amdgcn_s_setprio(1); _Pragma("unroll") for (int m = 0; m < 4; ++m) _Pragma("unroll") for (int n = 0; n < 2; ++n) _Pragma("unroll") for (int k = 0; k < 2; ++k) \
        acc[ai][bj][m][n] = __builtin_amdgcn_mfma_f32_16x16x32_bf16(Bt[n][k], At[m][k], acc[ai][bj][m][n], 0, 0, 0); __builtin_amdgcn_s_setprio(0); } while (0)
#define PG8_WAIT_V(n) asm volatile("s_waitcnt vmcnt(" #n ")" ::: "memory")
#define PG8_WAIT_L(n) asm volatile("s_waitcnt lgkmcnt(" #n ")" ::: "memory")
#define PG8_BAR __builtin_amdgcn_s_barrier()
#define PG8_SCHED __builtin_amdgcn_sched_barrier(0)
    Unit cur, nxt; int ui = 0;
    if (!S.next(0, cur)) return;
    f32x4 acc[2][2][4][2];
#pragma unroll
    for (int a = 0; a < 2; ++a)
#pragma unroll
        for (int b = 0; b < 2; ++b)
#pragma unroll
            for (int m = 0; m < 4; ++m)
#pragma unroll
                for (int n = 0; n < 2; ++n) acc[a][b][m][n] = (f32x4){0.f, 0.f, 0.f, 0.f};
    bf16x8 At[4][2], B0[2][2], B1[2][2];
    const char* cA = (const char*)g.A + (size_t)cur.pm * tstep; const char* cB = (const char*)g.Bt + (size_t)cur.pn * tstep;
    S.a_ready(cur);
    PG8_STAGE(PG8_SB(0, 0), cB, voffB); PG8_STAGE(PG8_SA(0, 0), cA, voffA); PG8_STAGE(PG8_SB(0, 1), cB + hstep, voffB); PG8_STAGE(PG8_SA(0, 1), cA + hstep, voffA);
    if (wr == 1) PG8_BAR;
    PG8_WAIT_V(4); PG8_BAR;
    PG8_STAGE(PG8_SB(1, 0), cB + kstep, voffB); PG8_STAGE(PG8_SA(1, 0), cA + kstep, voffA); PG8_STAGE(PG8_SB(1, 1), cB + hstep + kstep, voffB);
    PG8_WAIT_V(6); PG8_BAR;
    PG8_STAMP();
    for (;;) {
        const bool has_next = S.next(ui + 1, nxt);
        const char* nA = has_next ? (const char*)g.A + (size_t)nxt.pm * tstep : cA; const char* nB = has_next ? (const char*)g.Bt + (size_t)nxt.pn * tstep : cB;
        for (int t = 0; t < nt; t += 2) {
            const bool last = (t == nt - 2);
            const char* a1 = cA + (size_t)(t + 1) * kstep;
            const char* a2 = last ? nA : cA + (size_t)(t + 2) * kstep; const char* b2 = last ? nB : cB + (size_t)(t + 2) * kstep;
            const char* a3 = a2 + kstep; const char* b3 = b2 + kstep;
            if (last && has_next) S.a_ready(nxt);
            PG8_LDB(B0, 0, 0); PG8_SCHED; PG8_LDA(At, 0, 0); PG8_STAGE(PG8_SA(1, 1), a1 + hstep, voffA);
            PG8_WAIT_L(8); PG8_BAR; PG8_WAIT_L(0); PG8_MMA(0, 0, At, B0); PG8_BAR; PG8_SCHED;
            PG8_LDB(B1, 0, 1); PG8_STAGE(PG8_SB(0, 0), b2, voffB);
            PG8_BAR; PG8_WAIT_L(0); PG8_MMA(0, 1, At, B1); PG8_BAR;
            PG8_LDA(At, 0, 1); PG8_STAGE(PG8_SA(0, 0), a2, voffA);
            PG8_BAR; PG8_WAIT_L(0); PG8_MMA(1, 0, At, B0); PG8_BAR; PG8_SCHED;
            PG8_STAGE(PG8_SB(0, 1), b2 + hstep, voffB);
            PG8_WAIT_V(6); PG8_BAR; PG8_MMA(1, 1, At, B1); PG8_BAR;
            PG8_LDB(B0, 1, 0); PG8_SCHED; PG8_LDA(At, 1, 0); PG8_STAGE(PG8_SA(0, 1), a2 + hstep, voffA);
            PG8_WAIT_L(8); PG8_BAR; PG8_WAIT_L(0); PG8_MMA(0, 0, At, B0); PG8_BAR; PG8_SCHED;
            PG8_LDB(B1, 1, 1); PG8_STAGE(PG8_SB(1, 0), b3, voffB);
            PG8_BAR; PG8_WAIT_L(0); PG8_MMA(0, 1, At, B1); PG8_BAR;
            PG8_LDA(At, 1, 1); PG8_STAGE(PG8_SA(1, 0), a3, voffA);
            PG8_BAR; PG8_WAIT_L(0); PG8_MMA(1, 0, At, B0); PG8_BAR; PG8_SCHED;
            PG8_STAGE(PG8_SB(1, 1), b3 + hstep, voffB);
            PG8_WAIT_V(6); PG8_BAR; PG8_MMA(1, 1, At, B1); PG8_BAR;
        }
        PG8_STAMP();
        if constexpr (!Epi::AFTER_DRAIN) { E(acc, cur, wr, wc, fr, fq); S.done(cur); }
        PG8_STAMP();
        if (!has_next) break;
#pragma unroll
        for (int a = 0; a < 2; ++a)
#pragma unroll
            for (int b = 0; b < 2; ++b)
#pragma unroll
                for (int m = 0; m < 4; ++m)
#pragma unroll
                    for (int n = 0; n < 2; ++n) acc[a][b][m][n] = (f32x4){0.f, 0.f, 0.f, 0.f};
        cur = nxt; cA = nA; cB = nB; ++ui;
    }
    PG8_WAIT_V(0);
    if (wr == 0) PG8_BAR;
    PG8_BAR;
    if constexpr (Epi::AFTER_DRAIN) { E.fused(acc, cur, wr, wc, fr, fq, lds, wid, lane); S.done(cur); }
    PG8_STAMP();
    if (STAMP && wid == 0) { stamps[lane] = lane < nts ? (((unsigned long long)(unsigned)ts_hi << 32) | (unsigned)ts_lo) : 0ull;
        if (lane == 62) stamps[62] = rt_entry; if (lane == 63) stamps[63] = (unsigned long long)wall_clock64(); }
#undef PG8_STAMP
#undef PG8_SA
#undef PG8_SB
#undef PG8_STAGE
#undef PG8_LDA
#undef PG8_LDB
#undef PG8_MMA
#undef PG8_WAIT_V
#undef PG8_WAIT_L
#undef PG8_BAR
#undef PG8_SCHED
}
}
using pg8::bf16_t; using pg8::bf16x8; using pg8::f32x4; using pg8::u32x4;
typedef unsigned u32x2 __attribute__((ext_vector_type(2)));
#define DI __device__ __forceinline__
#define LAS __attribute__((address_space(3)))

constexpr int DM = 2048, NB = 4, SEQ = 2048, CTX = 256, LROWS = NB * SEQ, TROWS = LROWS + NB * CTX;
constexpr int DFF = 5504, NIN = 18464, NINP = 18688, NMOD = 6 * DM;
constexpr float EPSN = 1e-6f;
constexpr size_t MiB = 1ull << 20;
constexpr size_t W_INT = 0, W_KRT = 0, W_VRT = 36 * MiB, W_UPT = 0, W_DNT = 43 * MiB;
constexpr size_t W_H = 73 * MiB, W_VGT = 73 * MiB, W_H2 = 73 * MiB;
constexpr size_t W_RPT = 109 * MiB, W_GPT = 117 * MiB, W_OT = 125 * MiB;
constexpr size_t W_MOD = 133 * MiB, W_CDF = W_MOD + 256 * 1024, W_CDB = W_CDF + 640 * 1024, W_COS = 135 * MiB, W_SIN = 136 * MiB;
constexpr size_t W_RQ = 138 * MiB, W_RK = 170 * MiB, W_RV = 206 * MiB, W_GQ = 242 * MiB, W_GK = 258 * MiB, W_GV = 276 * MiB,
                 W_RG = 312 * MiB, W_GG = 344 * MiB, W_MR = 376 * MiB, W_MG = 408 * MiB, W_GAB = 440 * MiB;
constexpr size_t W_QF = 444 * MiB + 512 * 1024, W_QB = W_QF + 16 * MiB, W_KF = W_QB + 16 * MiB, W_KB = W_KF + 18 * MiB, W_KTF = W_KB + 18 * MiB, W_KTB = W_KTF + 18 * MiB;
constexpr size_t W_ORF = W_RV, W_ORB = W_GQ, W_OGF = W_GV;
constexpr size_t W_R = W_QF, W_G = W_R + 32 * MiB, W_Z = W_G + 32 * MiB, W_T = W_RQ;
constexpr size_t W_AV = 138 * MiB, W_U = 312 * MiB;
constexpr size_t W_PART = W_KTB + 18 * MiB;
constexpr size_t W_END = W_PART + 4 * MiB;

struct Params {
    const float *x, *c, *ctx, *c_ctx, *w_ada, *b_ada, *norm1_g, *w_in, *ret_decay, *gate_up, *gate_bias, *ret_g, *gla_g,
                *w_rp, *w_gp, *w_o, *norm2_g, *w_up, *conv_w, *conv_b, *w_down, *final_g;
    float* out; unsigned char* ws;
};

DI float bf2f(unsigned short b) { return __uint_as_float(((unsigned)b) << 16); }
DI unsigned pk2(float a, float b) { __hip_bfloat162 r = __float22bfloat162_rn(make_float2(a, b)); return *reinterpret_cast<unsigned*>(&r); }
DI unsigned short f2bf(float a) { return (unsigned short)(pk2(a, 0.f) & 0xffffu); }
DI float lo16(unsigned u) { return __uint_as_float(u << 16); }
DI float hi16(unsigned u) { return __uint_as_float(u & 0xffff0000u); }
DI float sigmoidf_(float x) { return 1.0f / (1.0f + __expf(-x)); }
DI float siluf_(float x) { return x * sigmoidf_(x); }
DI float logsigmoidf_(float x) { return fminf(x, 0.f) - log1pf(expf(-fabsf(x))); }
DI float wave_sum(float v) { for (int o = 32; o >= 1; o >>= 1) v += __shfl_xor(v, o); return v; }

struct MapPlain { DI int src(int n) const { return n; } DI float scale(int) const { return 1.f; } };
struct MapIn {
    DI int src(int n) const { return n < 14336 ? n : (n < 18432 ? n + 32 : (n < 18464 ? n - 18432 + 14336 : -1)); }
    DI float scale(int s) const { return ((s >= 2048 && s < 4096) || (s >= 9216 && s < 10240)) ? 0.0625f : 1.f; }
};
template <class Map> DI void convert_T(const float* __restrict__ src, int K, int ldsrc, bf16_t* __restrict__ dst, int Nd, Map map, LAS unsigned char* lds) {
    LAS unsigned short* T = (LAS unsigned short*)lds;
    const int tid = threadIdx.x, nkt = K / 64, ntiles = (Nd / 64) * nkt;
    for (int t = blockIdx.x; t < ntiles; t += gridDim.x) {
        const int n0 = (t / nkt) * 64, k0 = (t % nkt) * 64;
        const int kr = tid >> 4, c4 = tid & 15, sc = map.src(n0 + 4 * c4);
        const float s = sc >= 0 ? map.scale(sc) : 0.f;
#pragma unroll
        for (int i = 0; i < 2; ++i) {
            const int k = kr + 32 * i;
            f32x4 v = (f32x4){0.f, 0.f, 0.f, 0.f};
            if (sc >= 0) v = *(const f32x4*)(src + (size_t)(k0 + k) * ldsrc + sc);
#pragma unroll
            for (int j = 0; j < 4; ++j) T[(4 * c4 + j) * 66 + k] = f2bf(v[j] * s);
        }
        __syncthreads();
        const int n = tid >> 3, ks = tid & 7;
        const LAS unsigned* rp = (const LAS unsigned*)(T + n * 66 + 8 * ks);
        u32x4 w; w.x = rp[0]; w.y = rp[1]; w.z = rp[2]; w.w = rp[3];
        *(u32x4*)(dst + (size_t)(n0 + n) * K + k0 + 8 * ks) = w;
        __syncthreads();
    }
}
DI void ada_reduce(const Params& p) {
    const float* part = (const float*)(p.ws + W_PART); float* mod = (float*)(p.ws + W_MOD);
    for (int i = blockIdx.x * 512 + threadIdx.x; i < 5 * NMOD; i += gridDim.x * 512) { float s = 0.f; for (int kp = 0; kp < 16; ++kp) s += part[(size_t)kp * 5 * NMOD + i]; mod[i] = s; }
}
DI void ada_phase(const Params& p) {
    float* part = (float*)(p.ws + W_PART);
    const int lane = threadIdx.x & 63, gw = blockIdx.x * 8 + (threadIdx.x >> 6), nw = gridDim.x * 8;
    for (int it = gw; it < 48 * 16; it += nw) {
        const int cgp = it % 48, kp = it / 48, n = cgp * 256 + 4 * lane;
        f32x4 acc[5];
#pragma unroll
        for (int v = 0; v < 5; ++v) acc[v] = (f32x4){0.f, 0.f, 0.f, 0.f};
        for (int k = kp * 128; k < kp * 128 + 128; ++k) {
            const f32x4 w = *(const f32x4*)(p.w_ada + (size_t)k * NMOD + n);
#pragma unroll
            for (int v = 0; v < 5; ++v) { const float cv = v < 4 ? p.c[v * DM + k] : p.c_ctx[k]; acc[v] += w * siluf_(cv); }
        }
#pragma unroll
        for (int v = 0; v < 5; ++v) *(f32x4*)(part + ((size_t)kp * 5 + v) * NMOD + n) = acc[v];
    }
}
DI void rope_table(const Params& p) {
    float* tc = (float*)(p.ws + W_COS); float* ts = (float*)(p.ws + W_SIN);
    for (int i = blockIdx.x * 512 + threadIdx.x; i < SEQ * 128; i += gridDim.x * 512) {
        const int pos = i >> 7, d = i & 127, j = d & 63;
        const float inv = powf(10000.0f, -(float)j / 64.0f);
        const float a = (d < 64 ? (float)(pos >> 6) : (float)(pos & 63)) * inv;
        tc[i] = cosf(a); ts[i] = sinf(a);
    }
}
template <int MODE> DI void norm_phase(const Params& p, int nrows, const float* src_lat, const float* src_ctx, const float* gain, int sh_off, int sc_off, bf16_t* outb, float* outf) {
    const float* mod = (const float*)(p.ws + W_MOD);
    const int lane = threadIdx.x & 63, gw = blockIdx.x * 8 + (threadIdx.x >> 6), nw = gridDim.x * 8;
    for (int row = gw; row < nrows; row += nw) {
        const float* s = row < LROWS ? src_lat + (size_t)row * DM : src_ctx + (size_t)(row - LROWS) * DM;
        const int v = row < LROWS ? row / SEQ : 4;
        f32x4 t[8]; float ss = 0.f;
#pragma unroll
        for (int i = 0; i < 8; ++i) { t[i] = *(const f32x4*)(s + 4 * lane + 256 * i); ss += t[i][0] * t[i][0] + t[i][1] * t[i][1] + t[i][2] * t[i][2] + t[i][3] * t[i][3]; }
        ss = wave_sum(ss);
        const float rs = rsqrtf(ss * (1.0f / DM) + EPSN);
#pragma unroll
        for (int i = 0; i < 8; ++i) {
            const int col = 4 * lane + 256 * i;
            const f32x4 g = *(const f32x4*)(gain + col);
            if (MODE == 0) {
                const f32x4 sh = *(const f32x4*)(mod + v * NMOD + sh_off + col) + *(const f32x4*)(p.b_ada + sh_off + col);
                const f32x4 sc = *(const f32x4*)(mod + v * NMOD + sc_off + col) + *(const f32x4*)(p.b_ada + sc_off + col);
                const f32x4 y = (t[i] * rs) * g * (sc + 1.0f) + sh;
                u32x2 w; w.x = pk2(y[0], y[1]); w.y = pk2(y[2], y[3]);
                *(u32x2*)(outb + (size_t)row * DM + col) = w;
            } else {
                *(f32x4*)(outf + (size_t)row * DM + col) = (t[i] * rs) * g;
            }
        }
    }
}
struct SchedIn {
    pg8::StaticOrder so; int G, c;
    DI void init(int G_, int c_) { so.init(LROWS, NINP, G_, c_); G = G_; c = c_; }
    DI bool next(int i, pg8::Unit& u) const {
        const int L = i * G + c;
        if (L < 32 * 73) return so.next(i, u);
        const int j = L - 32 * 73; if (j >= 4 * 29) return false;
        u.pm = 32 + (j & 3); const int q = j >> 2;
        u.pn = q < 8 ? 8 + q : (q < 16 ? 16 + (q - 8) : (q < 20 ? 36 + (q - 16) : (q < 28 ? 40 + (q - 20) : 72)));
        return true;
    }
    DI void a_ready(const pg8::Unit&) const {}
    DI void done(const pg8::Unit&) const {}
};
struct EpiIn {
    static constexpr bool PERM = true, AFTER_DRAIN = false;
    unsigned char* ws;
    DI void operator()(const f32x4 (&acc)[2][2][4][2], const pg8::Unit& u, int wr, int wc, int fr, int fq) const {
        const int pn = u.pn; size_t off; int ld, ct;
        if (pn < 8) { off = W_RQ; ld = 2048; ct = pn; } else if (pn < 16) { off = W_RK; ld = 2048; ct = pn - 8; } else if (pn < 24) { off = W_RV; ld = 2048; ct = pn - 16; }
        else if (pn < 32) { off = W_RG; ld = 2048; ct = pn - 24; } else if (pn < 36) { off = W_GQ; ld = 1024; ct = pn - 32; } else if (pn < 40) { off = W_GK; ld = 1024; ct = pn - 36; }
        else if (pn < 48) { off = W_GV; ld = 2048; ct = pn - 40; } else if (pn < 56) { off = W_GG; ld = 2048; ct = pn - 48; } else if (pn < 64) { off = W_MR; ld = 2048; ct = pn - 56; }
        else if (pn < 72) { off = W_MG; ld = 2048; ct = pn - 64; } else { off = W_GAB; ld = 256; ct = 0; }
        bf16_t* base = (bf16_t*)(ws + off);
        const int row0 = u.pm * 256 + wr * 64 + fr, col0 = ct * 256 + wc * 32 + 8 * fq;
#pragma unroll
        for (int ai = 0; ai < 2; ++ai)
#pragma unroll
            for (int m = 0; m < 4; ++m) { bf16_t* rowp = base + (size_t)(row0 + ai * 128 + m * 16) * ld + col0;
#pragma unroll
                for (int bj = 0; bj < 2; ++bj) { const f32x4 v0 = acc[ai][bj][m][0], v1 = acc[ai][bj][m][1];
                    u32x4 w; w.x = pg8::cvt_pk_bf16(v0[0], v0[1]); w.y = pg8::cvt_pk_bf16(v0[2], v0[3]); w.z = pg8::cvt_pk_bf16(v1[0], v1[1]); w.w = pg8::cvt_pk_bf16(v1[2], v1[3]);
                    *(u32x4*)(rowp + bj * 128) = w; } }
    }
};
template <int MODE> struct EpiB {
    static constexpr bool PERM = true, AFTER_DRAIN = false;
    bf16_t* O; int ld; const bf16_t* g1; const bf16_t* add;
    DI void operator()(const f32x4 (&acc)[2][2][4][2], const pg8::Unit& u, int wr, int wc, int fr, int fq) const {
        const int row0 = u.pm * 256 + wr * 64 + fr, col0 = u.pn * 256 + wc * 32 + 8 * fq;
#pragma unroll
        for (int ai = 0; ai < 2; ++ai)
#pragma unroll
            for (int m = 0; m < 4; ++m) { const size_t ro = (size_t)(row0 + ai * 128 + m * 16) * ld + col0;
#pragma unroll
                for (int bj = 0; bj < 2; ++bj) { f32x4 v0 = acc[ai][bj][m][0], v1 = acc[ai][bj][m][1];
                    if (MODE >= 1) { const u32x4 gg = *(const u32x4*)(g1 + ro + bj * 128);
                        v0[0] *= sigmoidf_(lo16(gg.x)); v0[1] *= sigmoidf_(hi16(gg.x)); v0[2] *= sigmoidf_(lo16(gg.y)); v0[3] *= sigmoidf_(hi16(gg.y));
                        v1[0] *= sigmoidf_(lo16(gg.z)); v1[1] *= sigmoidf_(hi16(gg.z)); v1[2] *= sigmoidf_(lo16(gg.w)); v1[3] *= sigmoidf_(hi16(gg.w)); }
                    if (MODE == 2) { const u32x4 aa = *(const u32x4*)(add + ro + bj * 128);
                        v0[0] += lo16(aa.x); v0[1] += hi16(aa.x); v0[2] += lo16(aa.y); v0[3] += hi16(aa.y);
                        v1[0] += lo16(aa.z); v1[1] += hi16(aa.z); v1[2] += lo16(aa.w); v1[3] += hi16(aa.w); }
                    u32x4 w; w.x = pg8::cvt_pk_bf16(v0[0], v0[1]); w.y = pg8::cvt_pk_bf16(v0[2], v0[3]); w.z = pg8::cvt_pk_bf16(v1[0], v1[1]); w.w = pg8::cvt_pk_bf16(v1[2], v1[3]);
                    *(u32x4*)(O + ro + bj * 128) = w; } }
    }
};
struct EpiRes {
    static constexpr bool PERM = false, AFTER_DRAIN = false;
    const float* base; float* out; const float* mod; const float* b_ada; int goff;
    DI void operator()(const f32x4 (&acc)[2][2][4][2], const pg8::Unit& u, int wr, int wc, int fr, int fq) const {
        const int row0 = u.pm * 256 + wr * 64 + fr, col0 = u.pn * 256 + wc * 32 + 4 * fq, b = u.pm >> 3;
        f32x4 gv[2][2];
#pragma unroll
        for (int bj = 0; bj < 2; ++bj)
#pragma unroll
            for (int n = 0; n < 2; ++n) gv[bj][n] = *(const f32x4*)(mod + b * NMOD + goff + col0 + bj * 128 + n * 16) + *(const f32x4*)(b_ada + goff + col0 + bj * 128 + n * 16);
#pragma unroll
        for (int ai = 0; ai < 2; ++ai)
#pragma unroll
            for (int m = 0; m < 4; ++m) { const size_t ro = (size_t)(row0 + ai * 128 + m * 16) * DM + col0;
#pragma unroll
                for (int bj = 0; bj < 2; ++bj)
#pragma unroll
                    for (int n = 0; n < 2; ++n) { const f32x4 bs = *(const f32x4*)(base + ro + bj * 128 + n * 16); *(f32x4*)(out + ro + bj * 128 + n * 16) = bs + gv[bj][n] * acc[ai][bj][m][n]; } }
    }
};
template <class Epi> DI void run_gemm(LAS unsigned char* lds, const bf16_t* A, const bf16_t* Bt, int M, int N, int K, const Epi& E) {
    pg8::Gemm g; g.A = A; g.Bt = Bt; g.M = M; g.N = N; g.K = K;
    pg8::StaticOrder so; so.init(M, N, gridDim.x, blockIdx.x);
    pg8::gemm_phase<Epi, pg8::StaticOrder, false>(lds, g, so, E, nullptr);
}
DI void store_row64(bf16_t* dst, const unsigned (&pk)[32]) {
#pragma unroll
    for (int i = 0; i < 8; ++i) { u32x4 w; w.x = pk[4 * i]; w.y = pk[4 * i + 1]; w.z = pk[4 * i + 2]; w.w = pk[4 * i + 3]; *(u32x4*)(dst + 8 * i) = w; }
}
DI void transpose_v(const bf16_t* __restrict__ src, bf16_t* __restrict__ dst) {
    for (int it = blockIdx.x; it < 144 * 4; it += gridDim.x) {
        const int ch = it >> 2, col = (it & 3) * 512 + threadIdx.x;
        const bf16_t* s = src + (size_t)ch * 64 * 2048 + col;
        unsigned pk[32];
#pragma unroll
        for (int t = 0; t < 64; t += 2) pk[t >> 1] = (unsigned)s[(size_t)t * 2048] | ((unsigned)s[(size_t)(t + 1) * 2048] << 16);
        store_row64(dst + ((size_t)ch * 2048 + col) * 64, pk);
    }
}
DI void rope_q(const Params& p) {
    bf16_t* rq = (bf16_t*)(p.ws + W_RQ); const float* tc = (const float*)(p.ws + W_COS); const float* tsn = (const float*)(p.ws + W_SIN);
    for (int it = blockIdx.x; it < 128 * 4; it += gridDim.x) {
        const int ch = it >> 2, hp = it & 3, tid = threadIdx.x, d = tid & 127, h = hp * 2 + ((tid >> 7) & 1), tq = tid >> 8;
        for (int t = tq; t < 64; t += 2) {
            const int row = ch * 64 + t, pos = row & (SEQ - 1);
            bf16_t* a = rq + (size_t)row * 2048 + h * 256 + d;
            const float x1 = bf2f(a[0]), x2 = bf2f(a[128]), cs = tc[pos * 128 + d], sn = tsn[pos * 128 + d];
            a[0] = f2bf(x1 * cs - x2 * sn); a[128] = f2bf(x2 * cs + x1 * sn);
        }
    }
}
DI void prep_rk(const Params& p) {
    bf16_t* rk = (bf16_t*)(p.ws + W_RK); bf16_t* krt = (bf16_t*)(p.ws + W_KRT); const float* tc = (const float*)(p.ws + W_COS); const float* tsn = (const float*)(p.ws + W_SIN);
    for (int it = blockIdx.x; it < 144 * 2; it += gridDim.x) {
        const int ch = it >> 1, h = (it & 1) * 4 + (threadIdx.x >> 7), d = threadIdx.x & 127;
        const bool lat = ch < 128;
        bf16_t* a = rk + (size_t)ch * 64 * 2048 + h * 256 + d;
        unsigned p1[32], p2[32];
#pragma unroll
        for (int t = 0; t < 64; ++t) {
            const int pos = (ch * 64 + t) & (SEQ - 1);
            float x1 = bf2f(a[(size_t)t * 2048]), x2 = bf2f(a[(size_t)t * 2048 + 128]);
            unsigned short y1, y2;
            if (lat) { const float cs = tc[pos * 128 + d], sn = tsn[pos * 128 + d]; y1 = f2bf(x1 * cs - x2 * sn); y2 = f2bf(x2 * cs + x1 * sn); a[(size_t)t * 2048] = y1; a[(size_t)t * 2048 + 128] = y2; }
            else { y1 = f2bf(x1); y2 = f2bf(x2); }
            if (t & 1) { p1[t >> 1] |= (unsigned)y1 << 16; p2[t >> 1] |= (unsigned)y2 << 16; } else { p1[t >> 1] = y1; p2[t >> 1] = y2; }
        }
        store_row64(krt + ((size_t)ch * 2048 + h * 256 + d) * 64, p1);
        store_row64(krt + ((size_t)ch * 2048 + h * 256 + d + 128) * 64, p2);
    }
}
template <int DIR> DI void prep_gla_dir(const Params& p, int ch, int h, int cch, LAS const float* ga) {
    const int col = h * 256 + cch;
    const bf16_t* gq = (const bf16_t*)(p.ws + W_GQ); const bf16_t* gk = (const bf16_t*)(p.ws + W_GK);
    bf16_t* qo = (bf16_t*)(p.ws + (DIR ? W_QB : W_QF)); bf16_t* ko = (bf16_t*)(p.ws + (DIR ? W_KB : W_KF)); bf16_t* kto = (bf16_t*)(p.ws + (DIR ? W_KTB : W_KTF));
    float* cd = (float*)(p.ws + (DIR ? W_CDB : W_CDF));
    float up[16];
#pragma unroll
    for (int r = 0; r < 16; ++r) up[r] = p.gate_up[((size_t)DIR * 16 + r) * 1024 + col];
    const float bias = p.gate_bias[DIR * 1024 + col];
    const bool lat = ch < 128;
    unsigned pk[32]; float b = 0.f;
#pragma unroll
    for (int tt = 0; tt < 64; ++tt) {
        const int t = DIR ? 63 - tt : tt; const size_t row = (size_t)ch * 64 + t;
        float z = bias;
#pragma unroll
        for (int r = 0; r < 16; ++r) z += ga[t * 32 + DIR * 16 + r] * up[r];
        b += logsigmoidf_(z) * 0.0625f;
        const float eb = __expf(b), ebi = __expf(-b);
        if (lat) qo[row * 1024 + col] = f2bf(bf2f(gq[row * 1024 + col]) * eb);
        const unsigned short kk = f2bf(bf2f(gk[row * 1024 + col]) * ebi);
        ko[row * 1024 + col] = kk;
        if (DIR == 0) { if (t & 1) pk[t >> 1] |= (unsigned)kk << 16; else pk[t >> 1] = kk; }
        else { if (t & 1) pk[t >> 1] = (unsigned)kk << 16; else pk[t >> 1] |= kk; }
    }
    cd[ch * 1024 + col] = __expf(b);
    store_row64(kto + ((size_t)ch * 1024 + col) * 64, pk);
}
DI void prep_gla(const Params& p, LAS unsigned char* lds) {
    LAS float* ga = (LAS float*)lds;
    const bf16_t* gab = (const bf16_t*)(p.ws + W_GAB);
    for (int it = blockIdx.x; it < 144 * 4; it += gridDim.x) {
        const int ch = it >> 2, h = it & 3, tid = threadIdx.x;
        __syncthreads();
#pragma unroll
        for (int i = 0; i < 4; ++i) { const int e = tid + 512 * i, t = e >> 5, r = e & 31; ga[e] = bf2f(gab[((size_t)ch * 64 + t) * 256 + r]); }
        __syncthreads();
        if (tid < 256) prep_gla_dir<0>(p, ch, h, tid, ga); else prep_gla_dir<1>(p, ch, h, tid - 256, ga);
    }
}
#define MFMA16(a, b, c) __builtin_amdgcn_mfma_f32_16x16x32_bf16((a), (b), (c), 0, 0, 0)
constexpr int QP = 264, KTP = 72;
DI void scan_phase(const Params& p, LAS unsigned char* lds) {
    LAS bf16_t* Qs = (LAS bf16_t*)lds; LAS bf16_t* Ks = Qs + 64 * QP; LAS bf16_t* KTs = Ks + 64 * QP; LAS bf16_t* Sc = KTs + 256 * KTP;
    const int tid = threadIdx.x, wid = tid >> 6, lane = tid & 63, r = lane & 15, q = lane >> 4;
    for (int u = blockIdx.x; u < 256; u += gridDim.x) {
        const bool ret = u < 128; int b, h, dir, part;
        if (ret) { b = u >> 5; h = (u >> 2) & 7; dir = (u >> 1) & 1; part = u & 1; } else { const int v = u - 128; b = v >> 5; h = (v >> 3) & 3; dir = (v >> 2) & 1; part = v & 3; }
        const bf16_t* qb = (const bf16_t*)(p.ws + (ret ? W_RQ : (dir ? W_QB : W_QF))) + h * 256;
        const bf16_t* kb = (const bf16_t*)(p.ws + (ret ? W_RK : (dir ? W_KB : W_KF))) + h * 256;
        const bf16_t* ktb = (const bf16_t*)(p.ws + (ret ? W_KRT : (dir ? W_KTB : W_KTF)));
        const bf16_t* vtb = (const bf16_t*)(p.ws + (ret ? W_VRT : W_VGT));
        const int ldqk = ret ? 2048 : 1024, ktC = ldqk, vcol = ret ? h * 256 + part * 128 : h * 512 + part * 128;
        bf16_t* ob = (ret ? (bf16_t*)(p.ws + (dir ? W_ORB : W_ORF)) : (dir ? (bf16_t*)p.out : (bf16_t*)(p.ws + W_OGF))) + vcol + 16 * wid + r;
        const float* cdb = (const float*)(p.ws + (dir ? W_CDB : W_CDF)) + h * 256;
        float lg = 0.f, g64 = 1.f;
        if (ret) { lg = logsigmoidf_(p.ret_decay[dir * 8 + h]); g64 = expf(64.f * lg); }
        float vfac[2][8], ofac[4][4];
#pragma unroll
        for (int s = 0; s < 2; ++s)
#pragma unroll
            for (int j = 0; j < 8; ++j) { const int tok = 32 * s + 8 * q + j, i = dir ? 63 - tok : tok; vfac[s][j] = expf(-(float)(i + 1) * lg); }
#pragma unroll
        for (int nt = 0; nt < 4; ++nt)
#pragma unroll
            for (int j = 0; j < 4; ++j) { const int n = 16 * nt + 4 * q + j, i = dir ? 63 - n : n; ofac[nt][j] = expf((float)(i + 1) * lg); }
        f32x4 S[16]; bf16x8 Sb[8];
#pragma unroll
        for (int i = 0; i < 16; ++i) S[i] = (f32x4){0.f, 0.f, 0.f, 0.f};
#pragma unroll
        for (int i = 0; i < 8; ++i) Sb[i] = (bf16x8){0, 0, 0, 0, 0, 0, 0, 0};
        for (int st = 0; st < 36; ++st) {
            const bool lat = st >= 4;
            const int row0 = lat ? b * SEQ + 64 * (dir ? 35 - st : st - 4) : LROWS + b * CTX + 64 * (dir ? 3 - st : st);
            const int cid = row0 >> 6;
            __syncthreads();
            {
                const bf16_t* kts = ktb + ((size_t)cid * ktC + h * 256) * 64;
#pragma unroll
                for (int i = 0; i < 4; ++i) { const int idx = tid + 512 * i; *(LAS u32x4*)(KTs + (idx >> 3) * KTP + (idx & 7) * 8) = *(const u32x4*)(kts + (size_t)idx * 8); }
                const int rr = tid >> 3, c0 = (tid & 7) * 8;
#pragma unroll
                for (int i = 0; i < 4; ++i) *(LAS u32x4*)(Ks + rr * QP + c0 + 64 * i) = *(const u32x4*)(kb + (size_t)(row0 + rr) * ldqk + c0 + 64 * i);
                if (lat) {
#pragma unroll
                    for (int i = 0; i < 4; ++i) *(LAS u32x4*)(Qs + rr * QP + c0 + 64 * i) = *(const u32x4*)(qb + (size_t)(row0 + rr) * ldqk + c0 + 64 * i);
                }
            }
            bf16x8 vf[2];
#pragma unroll
            for (int s = 0; s < 2; ++s) vf[s] = *(const bf16x8*)(vtb + ((size_t)cid * 2048 + vcol + 16 * wid + r) * 64 + 32 * s + 8 * q);
            if (ret) {
#pragma unroll
                for (int s = 0; s < 2; ++s)
#pragma unroll
                    for (int j = 0; j < 8; ++j) vf[s][j] = (short)f2bf(bf2f((unsigned short)vf[s][j]) * vfac[s][j]);
            }
            __syncthreads();
            if (lat) {
                const int mt = wid & 3, nt0 = (wid >> 2) * 2;
                f32x4 sc0 = (f32x4){0.f, 0.f, 0.f, 0.f}, sc1 = sc0;
#pragma unroll
                for (int ks = 0; ks < 8; ++ks) {
                    const bf16x8 a = *(const LAS bf16x8*)(Ks + (16 * mt + r) * QP + 32 * ks + 8 * q);
                    const bf16x8 b0 = *(const LAS bf16x8*)(Qs + (16 * nt0 + r) * QP + 32 * ks + 8 * q);
                    const bf16x8 b1 = *(const LAS bf16x8*)(Qs + (16 * nt0 + 16 + r) * QP + 32 * ks + 8 * q);
                    sc0 = MFMA16(a, b0, sc0); sc1 = MFMA16(a, b1, sc1);
                }
                {
                    const int m0 = 16 * mt + 4 * q, n0 = 16 * nt0 + r, n1 = n0 + 16;
#pragma unroll
                    for (int j = 0; j < 4; ++j) { const int m = m0 + j; if (dir ? (n0 > m) : (n0 < m)) sc0[j] = 0.f; if (dir ? (n1 > m) : (n1 < m)) sc1[j] = 0.f; }
                    u32x2 w0, w1; w0.x = pk2(sc0[0], sc0[1]); w0.y = pk2(sc0[2], sc0[3]); w1.x = pk2(sc1[0], sc1[1]); w1.y = pk2(sc1[2], sc1[3]);
                    *(LAS u32x2*)(Sc + n0 * KTP + m0) = w0; *(LAS u32x2*)(Sc + n1 * KTP + m0) = w1;
                }
                f32x4 o[4];
#pragma unroll
                for (int nt = 0; nt < 4; ++nt) o[nt] = (f32x4){0.f, 0.f, 0.f, 0.f};
#pragma unroll
                for (int ks = 0; ks < 8; ++ks)
#pragma unroll
                    for (int nt = 0; nt < 4; ++nt) {
                        const u32x2 lo = *(const LAS u32x2*)(Qs + (16 * nt + r) * QP + 32 * ks + 4 * q), hi = *(const LAS u32x2*)(Qs + (16 * nt + r) * QP + 32 * ks + 16 + 4 * q);
                        u32x4 aa; aa.x = lo.x; aa.y = lo.y; aa.z = hi.x; aa.w = hi.y;
                        o[nt] = MFMA16(__builtin_bit_cast(bf16x8, aa), Sb[ks], o[nt]);
                    }
                __syncthreads();
#pragma unroll
                for (int s = 0; s < 2; ++s)
#pragma unroll
                    for (int nt = 0; nt < 4; ++nt) { const bf16x8 a = *(const LAS bf16x8*)(Sc + (16 * nt + r) * KTP + 32 * s + 8 * q); o[nt] = MFMA16(a, vf[s], o[nt]); }
#pragma unroll
                for (int nt = 0; nt < 4; ++nt)
#pragma unroll
                    for (int j = 0; j < 4; ++j) ob[(size_t)(row0 + 16 * nt + 4 * q + j) * 2048] = f2bf(o[nt][j] * ofac[nt][j]);
            }
#pragma unroll
            for (int ct = 0; ct < 16; ++ct) {
#pragma unroll
                for (int s = 0; s < 2; ++s) { const bf16x8 a = *(const LAS bf16x8*)(KTs + (16 * ct + r) * KTP + 32 * s + 8 * q); S[ct] = MFMA16(a, vf[s], S[ct]); }
                if (ret) S[ct] *= g64; else S[ct] *= *(const f32x4*)(cdb + (size_t)cid * 1024 + 16 * ct + 4 * q);
            }
#pragma unroll
            for (int ks = 0; ks < 8; ++ks) { u32x4 w; w.x = pk2(S[2 * ks][0], S[2 * ks][1]); w.y = pk2(S[2 * ks][2], S[2 * ks][3]); w.z = pk2(S[2 * ks + 1][0], S[2 * ks + 1][1]); w.w = pk2(S[2 * ks + 1][2], S[2 * ks + 1][3]); Sb[ks] = __builtin_bit_cast(bf16x8, w); }
        }
    }
}
DI void readout_phase(const Params& p) {
    const bf16_t* orf = (const bf16_t*)(p.ws + W_ORF); const bf16_t* orb = (const bf16_t*)(p.ws + W_ORB); const bf16_t* ogf = (const bf16_t*)(p.ws + W_OGF); const bf16_t* ogb = (const bf16_t*)p.out;
    const bf16_t* rg = (const bf16_t*)(p.ws + W_RG); const bf16_t* gg = (const bf16_t*)(p.ws + W_GG); bf16_t* R = (bf16_t*)(p.ws + W_R); bf16_t* G = (bf16_t*)(p.ws + W_G);
    const int lane = threadIdx.x & 63, gw = blockIdx.x * 8 + (threadIdx.x >> 6), nw = gridDim.x * 8;
    for (int i = gw; i < LROWS * 12; i += nw) {
        const int tok = i / 12, j = i % 12;
        if (j < 8) {
            const size_t off = (size_t)tok * 2048 + j * 256 + 4 * lane;
            const u32x2 a = *(const u32x2*)(orf + off), bq = *(const u32x2*)(orb + off), gt = *(const u32x2*)(rg + off);
            float o[4] = {lo16(a.x) + lo16(bq.x), hi16(a.x) + hi16(bq.x), lo16(a.y) + lo16(bq.y), hi16(a.y) + hi16(bq.y)};
            const float mu = wave_sum(o[0] + o[1] + o[2] + o[3]) * (1.0f / 256.0f);
            float vs = 0.f;
#pragma unroll
            for (int e = 0; e < 4; ++e) { o[e] -= mu; vs += o[e] * o[e]; }
            const float rs = rsqrtf(wave_sum(vs) * (1.0f / 256.0f) + EPSN);
            const f32x4 gn = *(const f32x4*)(p.ret_g + j * 256 + 4 * lane);
            const float g4[4] = {lo16(gt.x), hi16(gt.x), lo16(gt.y), hi16(gt.y)};
            float y[4];
#pragma unroll
            for (int e = 0; e < 4; ++e) y[e] = o[e] * rs * gn[e] * siluf_(g4[e]);
            u32x2 w; w.x = pk2(y[0], y[1]); w.y = pk2(y[2], y[3]);
            *(u32x2*)(R + off) = w;
        } else {
            const int hh = j - 8; const size_t off = (size_t)tok * 2048 + hh * 512 + 8 * lane;
            const u32x4 a = *(const u32x4*)(ogf + off), bq = *(const u32x4*)(ogb + off), gt = *(const u32x4*)(gg + off);
            float o[8] = {lo16(a.x) + lo16(bq.x), hi16(a.x) + hi16(bq.x), lo16(a.y) + lo16(bq.y), hi16(a.y) + hi16(bq.y), lo16(a.z) + lo16(bq.z), hi16(a.z) + hi16(bq.z), lo16(a.w) + lo16(bq.w), hi16(a.w) + hi16(bq.w)};
            float vs = 0.f;
#pragma unroll
            for (int e = 0; e < 8; ++e) vs += o[e] * o[e];
            const float rs = rsqrtf(wave_sum(vs) * (1.0f / 512.0f) + EPSN);
            const f32x4 gn0 = *(const f32x4*)(p.gla_g + hh * 512 + 8 * lane), gn1 = *(const f32x4*)(p.gla_g + hh * 512 + 8 * lane + 4);
            const float g8[8] = {lo16(gt.x), hi16(gt.x), lo16(gt.y), hi16(gt.y), lo16(gt.z), hi16(gt.z), lo16(gt.w), hi16(gt.w)};
            float y[8];
#pragma unroll
            for (int e = 0; e < 8; ++e) y[e] = o[e] * rs * (e < 4 ? gn0[e] : gn1[e - 4]) * siluf_(g8[e]);
            u32x4 w; w.x = pk2(y[0], y[1]); w.y = pk2(y[2], y[3]); w.z = pk2(y[4], y[5]); w.w = pk2(y[6], y[7]);
            *(u32x4*)(G + off) = w;
        }
    }
}
DI float gelu_tanh(float x) { const float y = 0.7978845608028654f * (x + 0.044715f * x * x * x); const float t = 1.0f - 2.0f / (__expf(2.0f * y) + 1.0f); return 0.5f * x * (1.0f + t); }
DI void conv_phase(const Params& p) {
    const bf16_t* av = (const bf16_t*)(p.ws + W_AV); bf16_t* U = (bf16_t*)(p.ws + W_U);
    const int nth = gridDim.x * 512;
    for (int i = blockIdx.x * 512 + threadIdx.x; i < LROWS * 688; i += nth) {
        const int tok = i / 688, f8 = (i % 688) * 8, b = tok >> 11, pos = tok & 2047, rr = pos >> 6, cc = pos & 63;
        float acc[8];
        { const f32x4 c0 = *(const f32x4*)(p.conv_b + f8), c1 = *(const f32x4*)(p.conv_b + f8 + 4);
#pragma unroll
          for (int e = 0; e < 4; ++e) { acc[e] = c0[e]; acc[4 + e] = c1[e]; } }
#pragma unroll
        for (int dr = 0; dr < 3; ++dr) {
            const int r2 = rr + dr - 1; if (r2 < 0 || r2 > 31) continue;
#pragma unroll
            for (int dc = 0; dc < 3; ++dc) {
                const int c2 = cc + dc - 1; if (c2 < 0 || c2 > 63) continue;
                const u32x4 a = *(const u32x4*)(av + (size_t)(b * 2048 + r2 * 64 + c2) * 11008 + f8);
                const f32x4 w0 = *(const f32x4*)(p.conv_w + (dr * 3 + dc) * DFF + f8), w1 = *(const f32x4*)(p.conv_w + (dr * 3 + dc) * DFF + f8 + 4);
                acc[0] += lo16(a.x) * w0[0]; acc[1] += hi16(a.x) * w0[1]; acc[2] += lo16(a.y) * w0[2]; acc[3] += hi16(a.y) * w0[3];
                acc[4] += lo16(a.z) * w1[0]; acc[5] += hi16(a.z) * w1[1]; acc[6] += lo16(a.w) * w1[2]; acc[7] += hi16(a.w) * w1[3];
            }
        }
        const u32x4 v = *(const u32x4*)(av + (size_t)tok * 11008 + DFF + f8);
        const float v8[8] = {lo16(v.x), hi16(v.x), lo16(v.y), hi16(v.y), lo16(v.z), hi16(v.z), lo16(v.w), hi16(v.w)};
        float y[8];
#pragma unroll
        for (int e = 0; e < 8; ++e) y[e] = gelu_tanh(acc[e]) * v8[e];
        u32x4 w; w.x = pk2(y[0], y[1]); w.y = pk2(y[2], y[3]); w.z = pk2(y[4], y[5]); w.w = pk2(y[6], y[7]);
        *(u32x4*)(U + (size_t)tok * DFF + f8) = w;
    }
}
constexpr int LDS_BYTES = 131072, NPHASE = 15;
__global__ void __launch_bounds__(512, 2) fwd_megakernel(Params p, int ph_lo, int ph_hi) {
    extern __shared__ __attribute__((aligned(16))) unsigned char shm[];
    LAS unsigned char* lds = (LAS unsigned char*)shm;
    cg::grid_group grid = cg::this_grid();
    unsigned char* ws = p.ws;
    const float* mod = (const float*)(ws + W_MOD);
#define PHASE(k) if ((k) > ph_lo && (k) < ph_hi) grid.sync(); if ((k) >= ph_lo && (k) < ph_hi)
    {
        {
        PHASE(0) {
            convert_T(p.w_in, DM, NIN, (bf16_t*)(ws + W_INT), NINP, MapIn(), lds);
            convert_T(p.w_rp, DM, DM, (bf16_t*)(ws + W_RPT), DM, MapPlain(), lds);
            convert_T(p.w_gp, DM, DM, (bf16_t*)(ws + W_GPT), DM, MapPlain(), lds);
            convert_T(p.w_o, DM, DM, (bf16_t*)(ws + W_OT), DM, MapPlain(), lds);
            ada_phase(p); rope_table(p);
            }
        PHASE(1) { ada_reduce(p); }
        PHASE(2) { norm_phase<0>(p, TROWS, p.x, p.ctx, p.norm1_g, 0, DM, (bf16_t*)(ws + W_H), nullptr); }
        PHASE(3) { { pg8::Gemm g; g.A = (const bf16_t*)(ws + W_H); g.Bt = (const bf16_t*)(ws + W_INT); g.M = TROWS; g.N = NINP; g.K = DM;
                  SchedIn S; S.init(gridDim.x, blockIdx.x); EpiIn E; E.ws = ws;
                  pg8::gemm_phase<EpiIn, SchedIn, false>(lds, g, S, E, nullptr); } }
        PHASE(4) {
            rope_q(p); prep_rk(p);
            transpose_v((const bf16_t*)(ws + W_RV), (bf16_t*)(ws + W_VRT));
            transpose_v((const bf16_t*)(ws + W_GV), (bf16_t*)(ws + W_VGT));
            prep_gla(p, lds);
            }
        PHASE(5) { scan_phase(p, lds); }
        PHASE(6) {
            readout_phase(p);
            convert_T(p.w_up, DM, 2 * DFF, (bf16_t*)(ws + W_UPT), 2 * DFF, MapPlain(), lds);
            convert_T(p.w_down, DFF, DM, (bf16_t*)(ws + W_DNT), DM, MapPlain(), lds);
            }
        PHASE(7) { { EpiB<1> E; E.O = (bf16_t*)(ws + W_T); E.ld = DM; E.g1 = (const bf16_t*)(ws + W_MR); E.add = nullptr;
                  run_gemm(lds, (const bf16_t*)(ws + W_R), (const bf16_t*)(ws + W_RPT), LROWS, DM, DM, E); } }
        PHASE(8) { { EpiB<2> E; E.O = (bf16_t*)(ws + W_Z); E.ld = DM; E.g1 = (const bf16_t*)(ws + W_MG); E.add = (const bf16_t*)(ws + W_T);
                  run_gemm(lds, (const bf16_t*)(ws + W_G), (const bf16_t*)(ws + W_GPT), LROWS, DM, DM, E); } }
        PHASE(9) { { EpiRes E; E.base = p.x; E.out = p.out; E.mod = mod; E.b_ada = p.b_ada; E.goff = 2 * DM;
                  run_gemm(lds, (const bf16_t*)(ws + W_Z), (const bf16_t*)(ws + W_OT), LROWS, DM, DM, E); } }
        PHASE(10) { norm_phase<0>(p, LROWS, p.out, p.out, p.norm2_g, 3 * DM, 4 * DM, (bf16_t*)(ws + W_H2), nullptr); }
        PHASE(11) { { EpiB<0> E; E.O = (bf16_t*)(ws + W_AV); E.ld = 2 * DFF; E.g1 = nullptr; E.add = nullptr;
                   run_gemm(lds, (const bf16_t*)(ws + W_H2), (const bf16_t*)(ws + W_UPT), LROWS, 2 * DFF, DM, E); } }
        PHASE(12) { conv_phase(p); }
        PHASE(13) { { EpiRes E; E.base = p.out; E.out = p.out; E.mod = mod; E.b_ada = p.b_ada; E.goff = 5 * DM;
                   run_gemm(lds, (const bf16_t*)(ws + W_U), (const bf16_t*)(ws + W_DNT), LROWS, DM, DFF, E); } }
        PHASE(14) { norm_phase<1>(p, LROWS, p.out, p.out, p.final_g, 0, 0, nullptr, p.out); }
        }
    }
}


#ifndef CUT
#define CUT -1
#endif
__global__ void dump_kernel(Params p) {
    const unsigned short* w = (const unsigned short*)p.ws; const size_t n = W_END / 2, N = (size_t)LROWS * DM;
    for (size_t i = (size_t)blockIdx.x * 256 + threadIdx.x; i < N; i += (size_t)gridDim.x * 256) {
        float s = 0.f; for (size_t j = i; j < n; j += N) { const float v = bf2f(w[j]); s += (v == v && fabsf(v) < 1e30f) ? v : 1000.f; }
        p.out[i] = s;
    }
}
extern "C" void kernel_launch(void* const* d_in, const int* in_sizes, int n_in, void* d_out, int out_size, void* d_ws, size_t ws_size, hipStream_t stream) {
    static int grid = 0;
    if (grid == 0) {
        if (n_in != 22 || ws_size < W_END) { fprintf(stderr, "kernel_launch: unexpected inputs (n_in %d, ws %zu, need %zu)\n", n_in, ws_size, (size_t)W_END); grid = -1; return; }
        int dev = 0, cus = 0, per_cu = 0;
        (void)hipGetDevice(&dev); (void)hipDeviceGetAttribute(&cus, hipDeviceAttributeMultiprocessorCount, dev);
        if (hipFuncSetAttribute((const void*)fwd_megakernel, hipFuncAttributeMaxDynamicSharedMemorySize, LDS_BYTES) != hipSuccess) { fprintf(stderr, "hipFuncSetAttribute failed\n"); grid = -1; return; }
        if (hipOccupancyMaxActiveBlocksPerMultiprocessor(&per_cu, (const void*)fwd_megakernel, 512, LDS_BYTES) != hipSuccess || per_cu < 1) { fprintf(stderr, "occupancy query failed (%d)\n", per_cu); per_cu = 1; (void)hipGetLastError(); }
        grid = cus * per_cu;
        if (grid > 256) grid = 256;
    }
    if (grid < 0) return;
    Params p{};
    const float** pp = (const float**)&p;
    for (int i = 0; i < 22; ++i) pp[i] = (const float*)d_in[i];
    p.out = (float*)d_out; p.ws = (unsigned char*)d_ws;
#ifndef NLAUNCH
#define NLAUNCH 1
#endif
    for (int li = 0; li < NLAUNCH; ++li) {
        int lo = NLAUNCH == 1 ? 0 : li, hi = NLAUNCH == 1 ? (CUT >= 0 ? CUT + 1 : NPHASE) : li + 1;
        void* args[] = {&p, &lo, &hi};
        hipError_t e = hipLaunchCooperativeKernel((const void*)fwd_megakernel, dim3(grid), dim3(512), args, LDS_BYTES, stream);
        if (e != hipSuccess) { fprintf(stderr, "cooperative launch failed: %s (grid %d)\n", hipGetErrorString(e), grid); break; }
    }
    if (CUT >= 0) hipLaunchKernelGGL(dump_kernel, dim3(2048), dim3(256), 0, stream, p);
}
```

```cpp
#include <hip/hip_runtime.h>
#include <hip/hip_bf16.h>
#include <hip/hip_cooperative_groups.h>
#include <cstdio>
namespace cg = cooperative_groups;
namespace pg8 {
#define PG8_LAS __attribute__((address_space(3)))
typedef unsigned short bf16_t;
typedef short bf16x8 __attribute__((ext_vector_type(8)));
typedef float f32x4 __attribute__((ext_vector_type(4)));
typedef unsigned u32x4 __attribute__((ext_vector_type(4)));
constexpr int BM = 256, BK = 64, HALF = 128, HTB = HALF * BK * 2  , STAGE_BYTES = 8 * HTB, NXCD = 8, WGM = 8;

__host__ __device__ __forceinline__ int lds_byte(int r, int c) { const int st = (r >> 4) * 2 + (c >> 5), rr = r & 15, cc = c & 31, ob = rr * 64 + cc * 2; return st * 1024 + (ob ^ (((ob >> 9) & 1) << 5)); }
__host__ __device__ __forceinline__ void stage_rc(int b, int& R, int& C) { const int st = b / 1024, sb = b % 1024, swz = sb ^ (((sb >> 9) & 1) << 5); R = (st >> 1) * 16 + swz / 64; C = (st & 1) * 32 + (swz % 64) / 2; }
__host__ __device__ __forceinline__ int perm32(int rho) { const int n = rho >> 4, i = rho & 15; return 8 * (i >> 2) + 4 * n + (i & 3); }

struct Unit { int pm, pn; };
struct Gemm { const bf16_t* A; const bf16_t* Bt; int M, N, K; };

struct StaticOrder {
    int nM, nN, nwg, G, c;
    __host__ __device__ void init(int M, int N, int G_, int c_) { nM = M / BM; nN = N / BM; nwg = nM * nN; G = G_; c = c_; }
    __host__ __device__ bool next(int i, Unit& u) const {
        const long L = (long)i * G + c; if (L >= nwg) return false;
        int wgid = (int)L; { const int q = nwg / NXCD, r = nwg % NXCD, xcd = wgid % NXCD, off = wgid / NXCD; wgid = (xcd < r ? xcd * (q + 1) : r * (q + 1) + (xcd - r) * q) + off; }
        const int nig = WGM * nN, gid = wgid / nig, fm = gid * WGM, gsz = (nM - fm) < WGM ? (nM - fm) : WGM;
        u.pm = fm + ((wgid % nig) % gsz); u.pn = (wgid % nig) / gsz; return true;
    }
    __device__ __forceinline__ void a_ready(const Unit&) const {}
    __device__ __forceinline__ void done(const Unit&) const {}
};
__device__ __forceinline__ unsigned cvt_pk_bf16(float lo, float hi) { unsigned r; asm volatile("v_cvt_pk_bf16_f32 %0, %1, %2" : "=v"(r) : "v"(lo), "v"(hi)); return r; }
typedef float f32x2 __attribute__((ext_vector_type(2)));
__device__ __forceinline__ f32x2 gelu_pk(f32x2 v) {
    const f32x2 av = __builtin_elementwise_abs(v), d = av * 0.2316418882f + 1.0f;
    f32x2 t; t.x = __builtin_amdgcn_rcpf(d.x); t.y = __builtin_amdgcn_rcpf(d.y);
    f32x2 q = t * 0.5307027145f + (-0.7265760135f); q = q * t + 0.7107068705f; q = q * t + (-0.142248368f); q = q * t + 0.127414796f; q = q * t;
    const f32x2 s = (v * v) * (-0.72134752044f);
    f32x2 e; e.x = __builtin_amdgcn_exp2f(s.x); e.y = __builtin_amdgcn_exp2f(s.y);
    const f32x2 m = v * (q * e), r = v - m;
    f32x2 o; o.x = v.x < 0.f ? m.x : r.x; o.y = v.y < 0.f ? m.y : r.y; return o;
}
template <class Epi, class Sched, bool STAMP = false>
__device__ __forceinline__ void gemm_phase(PG8_LAS unsigned char* lds, const Gemm g, const Sched& S, const Epi& E, unsigned long long* stamps) {
    const int tid = threadIdx.x, wid = __builtin_amdgcn_readfirstlane(tid >> 6), lane = tid & 63, wr = wid >> 2, wc = wid & 3, fr = lane & 15, fq = lane >> 4;
    const int K = g.K, nt = K / BK;
    int ts_lo = 0, ts_hi = 0, nts = 0; const unsigned long long rt_entry = STAMP ? (unsigned long long)wall_clock64() : 0ull;
#define PG8_STAMP() do { if (STAMP && wid == 0 && nts < 64) { const unsigned long long _c = (unsigned long long)clock64(); \
        ts_lo = (lane == nts) ? (int)(unsigned)_c : ts_lo; ts_hi = (lane == nts) ? (int)(unsigned)(_c >> 32) : ts_hi; ++nts; } } while (0)
    PG8_STAMP();
    unsigned voffA[2], voffB[2];
#pragma unroll
    for (int i = 0; i < 2; ++i) { int R, C; stage_rc(tid * 16 + i * 8192, R, C); const int Rb = Epi::PERM ? ((R & ~31) + perm32(R & 31)) : R;
        voffA[i] = (unsigned)(R * K + C) * 2u; voffB[i] = (unsigned)(Rb * K + C) * 2u; }
    const size_t kstep = (size_t)(BK * 2);
    const size_t hstep = (size_t)HALF * K * 2;
    const size_t tstep = 2 * hstep;
    const unsigned ldsw = (unsigned)wid * 1024u;
    const int aoff = lds_byte(wr * 64 + fr, fq * 8), boff = lds_byte(wc * 32 + fr, fq * 8);
#define PG8_SA(b, h) (((b) * 2 + (h)) * HTB)
#define PG8_SB(b, h) ((4 + (b) * 2 + (h)) * HTB)
#define PG8_STAGE(bufoff, gbase, voff) do { _Pragma("unroll") for (int _i = 0; _i < 2; ++_i) \
        __builtin_amdgcn_global_load_lds((const unsigned*)((const char*)(gbase) + (voff)[_i]), (PG8_LAS unsigned*)(lds + (bufoff) + ldsw + _i * 8192), 16, 0, 0); } while (0)
#define PG8_LDA(dst, b, h) do { _Pragma("unroll") for (int m = 0; m < 4; ++m) _Pragma("unroll") for (int k = 0; k < 2; ++k) dst[m][k] = *(const PG8_LAS bf16x8*)(lds + PG8_SA(b, h) + aoff + m * 2048 + k * 1024); } while (0)
#define PG8_LDB(dst, b, h) do { _Pragma("unroll") for (int n = 0; n < 2; ++n) _Pragma("unroll") for (int k = 0; k < 2; ++k) dst[n][k] = *(const PG8_LAS bf16x8*)(lds + PG8_SB(b, h) + boff + n * 2048 + k * 1024); } while (0)
#define PG8_MMA(ai, bj, At, Bt) do { __builtin_amdgcn_s_setprio(1); _Pragma("unroll") for (int m = 0; m < 4; ++m) _Pragma("unroll") for (int n = 0; n < 2; ++n) _Pragma("unroll") for (int k = 0; k < 2; ++k) \
        acc[ai][bj][m][n] = __builtin_amdgcn_mfma_f32_16x16x32_bf16(Bt[n][k], At[m][k], acc[ai][bj][m][n], 0, 0, 0); __builtin_amdgcn_s_setprio(0); } while (0)
#define PG8_WAIT_V(n) asm volatile("s_waitcnt vmcnt(" #n ")" ::: "memory")
#define PG8_WAIT_L(n) asm volatile("s_waitcnt lgkmcnt(" #n ")" ::: "memory")
#define PG8_BAR __builtin_amdgcn_s_barrier()
#define PG8_SCHED __builtin_amdgcn_sched_barrier(0)
    Unit cur, nxt; int ui = 0;
    if (!S.next(0, cur)) return;
    f32x4 acc[2][2][4][2];
#pragma unroll
    for (int a = 0; a < 2; ++a)
#pragma unroll
        for (int b = 0; b < 2; ++b)
#pragma unroll
            for (int m = 0; m < 4; ++m)
#pragma unroll
                for (int n = 0; n < 2; ++n) acc[a][b][m][n] = (f32x4){0.f, 0.f, 0.f, 0.f};
    bf16x8 At[4][2], B0[2][2], B1[2][2];
    const char* cA = (const char*)g.A + (size_t)cur.pm * tstep; const char* cB = (const char*)g.Bt + (size_t)cur.pn * tstep;
    S.a_ready(cur);
    PG8_STAGE(PG8_SB(0, 0), cB, voffB); PG8_STAGE(PG8_SA(0, 0), cA, voffA); PG8_STAGE(PG8_SB(0, 1), cB + hstep, voffB); PG8_STAGE(PG8_SA(0, 1), cA + hstep, voffA);
    if (wr == 1) PG8_BAR;
    PG8_WAIT_V(4); PG8_BAR;
    PG8_STAGE(PG8_SB(1, 0), cB + kstep, voffB); PG8_STAGE(PG8_SA(1, 0), cA + kstep, voffA); PG8_STAGE(PG8_SB(1, 1), cB + hstep + kstep, voffB);
    PG8_WAIT_V(6); PG8_BAR;
    PG8_STAMP();
    for (;;) {
        const bool has_next = S.next(ui + 1, nxt);
        const char* nA = has_next ? (const char*)g.A + (size_t)nxt.pm * tstep : cA; const char* nB = has_next ? (const char*)g.Bt + (size_t)nxt.pn * tstep : cB;
        for (int t = 0; t < nt; t += 2) {
            const bool last = (t == nt - 2);
            const char* a1 = cA + (size_t)(t + 1) * kstep;
            const char* a2 = last ? nA : cA + (size_t)(t + 2) * kstep; const char* b2 = last ? nB : cB + (size_t)(t + 2) * kstep;
            const char* a3 = a2 + kstep; const char* b3 = b2 + kstep;
            if (last && has_next) S.a_ready(nxt);
            PG8_LDB(B0, 0, 0); PG8_SCHED; PG8_LDA(At, 0, 0); PG8_STAGE(PG8_SA(1, 1), a1 + hstep, voffA);
            PG8_WAIT_L(8); PG8_BAR; PG8_WAIT_L(0); PG8_MMA(0, 0, At, B0); PG8_BAR; PG8_SCHED;
            PG8_LDB(B1, 0, 1); PG8_STAGE(PG8_SB(0, 0), b2, voffB);
            PG8_BAR; PG8_WAIT_L(0); PG8_MMA(0, 1, At, B1); PG8_BAR;
            PG8_LDA(At, 0, 1); PG8_STAGE(PG8_SA(0, 0), a2, voffA);
            PG8_BAR; PG8_WAIT_L(0); PG8_MMA(1, 0, At, B0); PG8_BAR; PG8_SCHED;
            PG8_STAGE(PG8_SB(0, 1), b2 + hstep, voffB);
            PG8_WAIT_V(6); PG8_BAR; PG8_MMA(1, 1, At, B1); PG8_BAR;
            PG8_LDB(B0, 1, 0); PG8_SCHED; PG8_LDA(At, 1, 0); PG8_STAGE(PG8_SA(0, 1), a2 + hstep, voffA);
            PG8_WAIT_L(8); PG8_BAR; PG8_WAIT_L(0); PG8_MMA(0, 0, At, B0); PG8_BAR; PG8_SCHED;
            PG8_LDB(B1, 1, 1); PG8_STAGE(PG8_SB(1, 0), b3, voffB);
            PG8_BAR; PG8_WAIT_L(0); PG8_MMA(0, 1, At, B1); PG8_BAR;
            PG8_LDA(At, 1, 1); PG8_STAGE(PG8_SA(1, 0), a3, voffA);
            PG8_BAR; PG8_WAIT_L(0); PG8_MMA(1, 0, At, B0); PG8_BAR; PG8_SCHED;
            PG8_STAGE(PG8_SB(1, 1), b3 + hstep, voffB);
            PG8_WAIT_V(6); PG8_BAR; PG8_MMA(1, 1, At, B1); PG8_BAR;
        }
        PG8_STAMP();
        if constexpr (!Epi::AFTER_DRAIN) { E(acc, cur, wr, wc, fr, fq); S.done(cur); }
        PG8_STAMP();
        if (!has_next) break;
#pragma unroll
        for (int a = 0; a < 2; ++a)
#pragma unroll
            for (int b = 0; b < 2; ++b)
#pragma unroll
                for (int m = 0; m < 4; ++m)
#pragma unroll
                    for (int n = 0; n < 2; ++n) acc[a][b][m][n] = (f32x4){0.f, 0.f, 0.f, 0.f};
        cur = nxt; cA = nA; cB = nB; ++ui;
    }
    PG8_WAIT_V(0);
    if (wr == 0) PG8_BAR;
    PG8_BAR;
    if constexpr (Epi::AFTER_DRAIN) { E.fused(acc, cur, wr, wc, fr, fq, lds, wid, lane); S.done(cur); }
    PG8_STAMP();
    if (STAMP && wid == 0) { stamps[lane] = lane < nts ? (((unsigned long long)(unsigned)ts_hi << 32) | (unsigned)ts_lo) : 0ull;
        if (lane == 62) stamps[62] = rt_entry; if (lane == 63) stamps[63] = (unsigned long long)wall_clock64(); }
#undef PG8_STAMP
#undef PG8_SA
#undef PG8_SB
#undef PG8_STAGE
#undef PG8_LDA
#undef PG8_LDB
#undef PG8_MMA
#undef PG8_WAIT_V
#undef PG8_WAIT_L
#undef PG8_BAR
#undef PG8_SCHED
}
}
using pg8::bf16_t; using pg8::bf16x8; using pg8::f32x4; using pg8::u32x4;
typedef unsigned u32x2 __attribute__((ext_vector_type(2)));
#define DI __device__ __forceinline__
#define LAS __attribute__((address_space(3)))

constexpr int DM = 2048, NB = 4, SEQ = 2048, CTX = 256, LROWS = NB * SEQ, TROWS = LROWS + NB * CTX;
constexpr int DFF = 5504, NIN = 18464, NINP = 18688, NMOD = 6 * DM;
constexpr float EPSN = 1e-6f;
constexpr size_t MiB = 1ull << 20;
constexpr size_t W_INT = 0, W_ORF = 0, W_ORB = 32 * MiB;
constexpr size_t W_H = 73 * MiB, W_OGF = 73 * MiB, W_H2 = 73 * MiB;
constexpr size_t W_RPT = 109 * MiB, W_GPT = 117 * MiB, W_OT = 125 * MiB;
constexpr size_t W_MOD = 133 * MiB, W_CDF = W_MOD + 256 * 1024, W_CDB = W_CDF + 640 * 1024, W_COS = 135 * MiB, W_SIN = 136 * MiB;
constexpr size_t W_SSQ = 137 * MiB;
constexpr size_t W_RQ = 138 * MiB, W_RK = 170 * MiB, W_RV = 206 * MiB, W_GQ = 242 * MiB, W_GK = 258 * MiB, W_GV = 276 * MiB,
                 W_RG = 312 * MiB, W_GG = 344 * MiB, W_MR = 376 * MiB, W_MG = 408 * MiB, W_GAB = 440 * MiB;
constexpr size_t W_QF = 444 * MiB + 512 * 1024, W_QB = W_QF + 16 * MiB, W_KF = W_QB + 16 * MiB, W_KB = W_KF + 18 * MiB;
constexpr size_t W_UPT = 512 * MiB + 512 * 1024, W_DNT = W_UPT + 43 * MiB;
constexpr size_t W_R = W_QF, W_G = W_R + 32 * MiB, W_T = W_RQ, W_Z = W_RK;
constexpr size_t W_AV = 138 * MiB, W_U = 312 * MiB;
constexpr size_t W_PART = 548 * MiB + 512 * 1024;
constexpr size_t W_END = 577 * MiB;

struct Params {
    const float *x, *c, *ctx, *c_ctx, *w_ada, *b_ada, *norm1_g, *w_in, *ret_decay, *gate_up, *gate_bias, *ret_g, *gla_g,
                *w_rp, *w_gp, *w_o, *norm2_g, *w_up, *conv_w, *conv_b, *w_down, *final_g;
    float* out; unsigned char* ws;
};

DI float bf2f(unsigned short b) { return __uint_as_float(((unsigned)b) << 16); }
typedef __bf16 bf16x2_t __attribute__((ext_vector_type(2)));
typedef float f32x2_t __attribute__((ext_vector_type(2)));
DI unsigned pk2(float a, float b) { const f32x2_t v = {a, b}; return __builtin_bit_cast(unsigned, __builtin_convertvector(v, bf16x2_t)); }
DI unsigned short f2bf(float a) { return (unsigned short)(pk2(a, 0.f) & 0xffffu); }
DI float lo16(unsigned u) { return __uint_as_float(u << 16); }
DI float hi16(unsigned u) { return __uint_as_float(u & 0xffff0000u); }
DI float sigmoidf_(float x) { return __builtin_amdgcn_rcpf(1.0f + __expf(-x)); }
DI float siluf_(float x) { return x * sigmoidf_(x); }
DI float logsigmoidf_(float x) { return fminf(x, 0.f) - log1pf(expf(-fabsf(x))); }
DI float wave_sum(float v) { for (int o = 32; o >= 1; o >>= 1) v += __shfl_xor(v, o); return v; }

struct MapPlain { DI int src(int n) const { return n; } DI float scale(int) const { return 1.f; } };
struct MapIn {
    DI int src(int n) const { return n < 14336 ? n : (n < 18432 ? n + 32 : (n < 18464 ? n - 18432 + 14336 : -1)); }
    DI float scale(int s) const { return ((s >= 2048 && s < 4096) || (s >= 9216 && s < 10240)) ? 0.0625f : 1.f; }
};
template <int KT, class Map> DI void convert_T(const float* __restrict__ src, int K, int ldsrc, bf16_t* __restrict__ dst, int Nd, Map map, LAS unsigned char* lds, int first, int stride) {
    constexpr int P = KT + 2;
    LAS unsigned short* T = (LAS unsigned short*)lds;
    const int tid = threadIdx.x, nkt = K / KT, ntiles = (Nd / 64) * nkt;
    const int kr = tid >> 4, c4 = tid & 15;
    __syncthreads();
    f32x4 v[KT / 32]; int sc = -1;
#define CVT_LOAD(t_) do { const int n0_ = ((t_) / nkt) * 64, k0_ = ((t_) % nkt) * KT; sc = map.src(n0_ + 4 * c4); \
        _Pragma("unroll") for (int i = 0; i < KT / 32; ++i) { v[i] = (f32x4){0.f, 0.f, 0.f, 0.f}; if (sc >= 0) v[i] = *(const f32x4*)(src + (size_t)(k0_ + kr + 32 * i) * ldsrc + sc); } } while (0)
    if (first < ntiles) CVT_LOAD(first);
    for (int t = first; t < ntiles; t += stride) {
        const int n0 = (t / nkt) * 64, k0 = (t % nkt) * KT;
        const float s = sc >= 0 ? map.scale(sc) : 0.f;
#pragma unroll
        for (int i = 0; i < KT / 32; ++i)
#pragma unroll
            for (int j = 0; j < 4; ++j) T[(4 * c4 + j) * P + kr + 32 * i] = f2bf(v[i][j] * s);
        if (t + stride < ntiles) CVT_LOAD(t + stride);
        __syncthreads();
        const int n = tid >> 3, ks = tid & 7;
#pragma unroll
        for (int i = 0; i < KT / 64; ++i) {
            const LAS unsigned* rp = (const LAS unsigned*)(T + n * P + 8 * ks + 64 * i);
            u32x4 w; w.x = rp[0]; w.y = rp[1]; w.z = rp[2]; w.w = rp[3];
            *(u32x4*)(dst + (size_t)(n0 + n) * K + k0 + 8 * ks + 64 * i) = w;
        }
        __syncthreads();
    }
#undef CVT_LOAD
}
DI void ada_phase(const Params& p, LAS unsigned char* lds) {
    float* mod = (float*)(p.ws + W_MOD);
    LAS float* sl = (LAS float*)lds;
    LAS float* red = sl + 5 * DM;
    __syncthreads();
    for (int i = threadIdx.x; i < 5 * DM; i += 512) { const int v = i >> 11, k = i & (DM - 1); sl[i] = siluf_(v < 4 ? p.c[v * DM + k] : p.c_ctx[k]); }
    __syncthreads();
    const int tid = threadIdx.x, cg4 = tid % 12, rl = tid / 12;
    for (int cb = blockIdx.x; cb < NMOD / 48; cb += gridDim.x) {
        const int n = cb * 48 + 4 * cg4;
        f32x4 acc[5];
#pragma unroll
        for (int v = 0; v < 5; ++v) acc[v] = (f32x4){0.f, 0.f, 0.f, 0.f};
        if (rl < 42) {
            for (int k0 = rl; k0 < DM; k0 += 42 * 7) {
                f32x4 w[7];
#pragma unroll
                for (int i = 0; i < 7; ++i) { const int k = k0 + 42 * i; w[i] = (f32x4){0.f, 0.f, 0.f, 0.f}; if (k < DM) w[i] = *(const f32x4*)(p.w_ada + (size_t)k * NMOD + n); }
#pragma unroll
                for (int i = 0; i < 7; ++i) { const int k = k0 + 42 * i; if (k < DM) {
#pragma unroll
                    for (int v = 0; v < 5; ++v) acc[v] += w[i] * sl[v * DM + k]; } }
            }
#pragma unroll
            for (int v = 0; v < 5; ++v) *(LAS f32x4*)(red + (rl * 12 + cg4) * 20 + 4 * v) = acc[v];
        }
        __syncthreads();
        if (tid < 240) {
            const int g = tid / 20, e = tid % 20; float s = 0.f;
            for (int r2 = 0; r2 < 42; ++r2) s += red[(r2 * 12 + g) * 20 + e];
            mod[(e >> 2) * NMOD + cb * 48 + 4 * g + (e & 3)] = s;
        }
        __syncthreads();
    }
}
DI void rope_table(const Params& p) {
    float* tc = (float*)(p.ws + W_COS); float* ts = (float*)(p.ws + W_SIN);
    for (int i = blockIdx.x * 512 + threadIdx.x; i < SEQ * 128; i += gridDim.x * 512) {
        const int pos = i >> 7, d = i & 127, j = d & 63;
        const float inv = powf(10000.0f, -(float)j / 64.0f);
        const float a = (d < 64 ? (float)(pos >> 6) : (float)(pos & 63)) * inv;
        tc[i] = cosf(a); ts[i] = sinf(a);
    }
}
template <int MODE> DI void norm_phase(const Params& p, int nrows, const float* src_lat, const float* src_ctx, const float* gain, int sh_off, int sc_off, bf16_t* outb, float* outf) {
    const float* mod = (const float*)(p.ws + W_MOD);
    const int lane = threadIdx.x & 63, gw = blockIdx.x * 8 + (threadIdx.x >> 6), nw = gridDim.x * 8;
    for (int rowa = gw; rowa < nrows; rowa += 2 * nw) {
        int rows[2] = {rowa, rowa + nw}; const bool has2 = rows[1] < nrows; if (!has2) rows[1] = rowa;
        f32x4 t[2][8]; float ss[2] = {0.f, 0.f};
#pragma unroll
        for (int k = 0; k < 2; ++k) { const int row = rows[k]; const float* s = row < LROWS ? src_lat + (size_t)row * DM : src_ctx + (size_t)(row - LROWS) * DM;
#pragma unroll
            for (int i = 0; i < 8; ++i) t[k][i] = *(const f32x4*)(s + 4 * lane + 256 * i); }
#pragma unroll
        for (int k = 0; k < 2; ++k) {
#pragma unroll
            for (int i = 0; i < 8; ++i) ss[k] += t[k][i][0] * t[k][i][0] + t[k][i][1] * t[k][i][1] + t[k][i][2] * t[k][i][2] + t[k][i][3] * t[k][i][3];
            ss[k] = wave_sum(ss[k]); }
#pragma unroll
        for (int k = 0; k < 2; ++k) {
            if (k == 1 && !has2) break;
            const int row = rows[k], v = row < LROWS ? row / SEQ : 4;
            const float rs = rsqrtf(ss[k] * (1.0f / DM) + EPSN);
#pragma unroll
            for (int i = 0; i < 8; ++i) {
                if (i == 4) __builtin_amdgcn_sched_barrier(0);
                const int col = 4 * lane + 256 * i;
                const f32x4 g = *(const f32x4*)(gain + col);
                if (MODE == 0) {
                    const f32x4 sh = *(const f32x4*)(mod + v * NMOD + sh_off + col) + *(const f32x4*)(p.b_ada + sh_off + col);
                    const f32x4 sc = *(const f32x4*)(mod + v * NMOD + sc_off + col) + *(const f32x4*)(p.b_ada + sc_off + col);
                    t[k][i] = (t[k][i] * rs) * g * (sc + 1.0f) + sh;
                } else t[k][i] = (t[k][i] * rs) * g;
            }
#pragma unroll
            for (int i = 0; i < 8; ++i) {
                const int col = 4 * lane + 256 * i;
                if (MODE == 0) { u32x2 w; w.x = pk2(t[k][i][0], t[k][i][1]); w.y = pk2(t[k][i][2], t[k][i][3]); *(u32x2*)(outb + (size_t)row * DM + col) = w; }
                else *(f32x4*)(outf + (size_t)row * DM + col) = t[k][i];
            }
        }
    }
}
struct SchedIn {
    pg8::StaticOrder so; int G, c;
    DI void init(int G_, int c_) { so.init(LROWS, NINP, G_, c_); G = G_; c = c_; }
    DI bool next(int i, pg8::Unit& u) const {
        const int L = i * G + c;
        if (L < 32 * 73) return so.next(i, u);
        const int j = L - 32 * 73; if (j >= 4 * 29) return false;
        u.pm = 32 + (j & 3); const int q = j >> 2;
        u.pn = q < 8 ? 8 + q : (q < 16 ? 16 + (q - 8) : (q < 20 ? 36 + (q - 16) : (q < 28 ? 40 + (q - 20) : 72)));
        return true;
    }
    DI void a_ready(const pg8::Unit&) const {}
    DI void done(const pg8::Unit&) const {}
};
struct EpiIn {
    static constexpr bool PERM = true, AFTER_DRAIN = false;
    unsigned char* ws;
    DI void operator()(const f32x4 (&acc)[2][2][4][2], const pg8::Unit& u, int wr, int wc, int fr, int fq) const {
        const int pn = u.pn; size_t off; int ld, ct;
        if (pn < 8) { off = W_RQ; ld = 2048; ct = pn; } else if (pn < 16) { off = W_RK; ld = 2048; ct = pn - 8; } else if (pn < 24) { off = W_RV; ld = 2048; ct = pn - 16; }
        else if (pn < 32) { off = W_RG; ld = 2048; ct = pn - 24; } else if (pn < 36) { off = W_GQ; ld = 1024; ct = pn - 32; } else if (pn < 40) { off = W_GK; ld = 1024; ct = pn - 36; }
        else if (pn < 48) { off = W_GV; ld = 2048; ct = pn - 40; } else if (pn < 56) { off = W_GG; ld = 2048; ct = pn - 48; } else if (pn < 64) { off = W_MR; ld = 2048; ct = pn - 56; }
        else if (pn < 72) { off = W_MG; ld = 2048; ct = pn - 64; } else { off = W_GAB; ld = 256; ct = 0; }
        bf16_t* base = (bf16_t*)(ws + off);
        const int row0 = u.pm * 256 + wr * 64 + fr, col0 = ct * 256 + wc * 32 + 8 * fq;
        const bool rope = pn < 16 && u.pm < 32;
        const float* tc = (const float*)(ws + W_COS); const float* tsn = (const float*)(ws + W_SIN);
#pragma unroll
        for (int ai = 0; ai < 2; ++ai)
#pragma unroll
            for (int mp = 0; mp < 2; ++mp) {
                f32x4 cs[2][4];
#pragma unroll
                for (int mi = 0; mi < 2; ++mi) { const int row = row0 + ai * 128 + (2 * mp + mi) * 16, to = (row & (SEQ - 1)) * 128 + wc * 32 + 8 * fq;
                    if (rope) { cs[mi][0] = *(const f32x4*)(tc + to); cs[mi][1] = *(const f32x4*)(tc + to + 4); cs[mi][2] = *(const f32x4*)(tsn + to); cs[mi][3] = *(const f32x4*)(tsn + to + 4); }
                    else { cs[mi][0] = cs[mi][1] = (f32x4){1.f, 1.f, 1.f, 1.f}; cs[mi][2] = cs[mi][3] = (f32x4){0.f, 0.f, 0.f, 0.f}; } }
#pragma unroll
                for (int mi = 0; mi < 2; ++mi) { const int m = 2 * mp + mi, row = row0 + ai * 128 + m * 16; bf16_t* rowp = base + (size_t)row * ld + col0;
                    f32x4 a0 = acc[ai][0][m][0], a1 = acc[ai][0][m][1], b0 = acc[ai][1][m][0], b1 = acc[ai][1][m][1];
                    if (rope) { const f32x4 c0 = cs[mi][0], c1 = cs[mi][1], s0 = cs[mi][2], s1 = cs[mi][3];
                        const f32x4 na0 = a0 * c0 - b0 * s0, nb0 = b0 * c0 + a0 * s0, na1 = a1 * c1 - b1 * s1, nb1 = b1 * c1 + a1 * s1;
                        a0 = na0; b0 = nb0; a1 = na1; b1 = nb1; }
                    u32x4 w; w.x = pg8::cvt_pk_bf16(a0[0], a0[1]); w.y = pg8::cvt_pk_bf16(a0[2], a0[3]); w.z = pg8::cvt_pk_bf16(a1[0], a1[1]); w.w = pg8::cvt_pk_bf16(a1[2], a1[3]);
                    *(u32x4*)rowp = w;
                    w.x = pg8::cvt_pk_bf16(b0[0], b0[1]); w.y = pg8::cvt_pk_bf16(b0[2], b0[3]); w.z = pg8::cvt_pk_bf16(b1[0], b1[1]); w.w = pg8::cvt_pk_bf16(b1[2], b1[3]);
                    *(u32x4*)(rowp + 128) = w; }
            }
    }
};
template <int MODE> struct EpiB {
    static constexpr bool PERM = true, AFTER_DRAIN = false;
    bf16_t* O; int ld; const bf16_t* g1; const bf16_t* add;
    DI void operator()(const f32x4 (&acc)[2][2][4][2], const pg8::Unit& u, int wr, int wc, int fr, int fq) const {
        const int row0 = u.pm * 256 + wr * 64 + fr, col0 = u.pn * 256 + wc * 32 + 8 * fq;
#pragma unroll
        for (int ai = 0; ai < 2; ++ai)
#pragma unroll
            for (int m = 0; m < 4; ++m) { const size_t ro = (size_t)(row0 + ai * 128 + m * 16) * ld + col0;
#pragma unroll
                for (int bj = 0; bj < 2; ++bj) { f32x4 v0 = acc[ai][bj][m][0], v1 = acc[ai][bj][m][1];
                    if (MODE >= 1) { const u32x4 gg = *(const u32x4*)(g1 + ro + bj * 128);
                        v0[0] *= sigmoidf_(lo16(gg.x)); v0[1] *= sigmoidf_(hi16(gg.x)); v0[2] *= sigmoidf_(lo16(gg.y)); v0[3] *= sigmoidf_(hi16(gg.y));
                        v1[0] *= sigmoidf_(lo16(gg.z)); v1[1] *= sigmoidf_(hi16(gg.z)); v1[2] *= sigmoidf_(lo16(gg.w)); v1[3] *= sigmoidf_(hi16(gg.w)); }
                    if (MODE == 2) { const u32x4 aa = *(const u32x4*)(add + ro + bj * 128);
                        v0[0] += lo16(aa.x); v0[1] += hi16(aa.x); v0[2] += lo16(aa.y); v0[3] += hi16(aa.y);
                        v1[0] += lo16(aa.z); v1[1] += hi16(aa.z); v1[2] += lo16(aa.w); v1[3] += hi16(aa.w); }
                    u32x4 w; w.x = pg8::cvt_pk_bf16(v0[0], v0[1]); w.y = pg8::cvt_pk_bf16(v0[2], v0[3]); w.z = pg8::cvt_pk_bf16(v1[0], v1[1]); w.w = pg8::cvt_pk_bf16(v1[2], v1[3]);
                    *(u32x4*)(O + ro + bj * 128) = w; } }
    }
};
struct EpiRes {
    static constexpr bool PERM = false, AFTER_DRAIN = false;
    const float* base; float* out; const float* mod; const float* b_ada; int goff;
    DI void operator()(const f32x4 (&acc)[2][2][4][2], const pg8::Unit& u, int wr, int wc, int fr, int fq) const {
        const int row0 = u.pm * 256 + wr * 64 + fr, col0 = u.pn * 256 + wc * 32 + 4 * fq, b = u.pm >> 3;
        f32x4 gv[2][2];
#pragma unroll
        for (int bj = 0; bj < 2; ++bj)
#pragma unroll
            for (int n = 0; n < 2; ++n) gv[bj][n] = *(const f32x4*)(mod + b * NMOD + goff + col0 + bj * 128 + n * 16) + *(const f32x4*)(b_ada + goff + col0 + bj * 128 + n * 16);
#pragma unroll
        for (int ai = 0; ai < 2; ++ai)
#pragma unroll
            for (int mp = 0; mp < 2; ++mp) {
                f32x4 bs[2][2][2];
#pragma unroll
                for (int mi = 0; mi < 2; ++mi)
#pragma unroll
                    for (int bj = 0; bj < 2; ++bj)
#pragma unroll
                        for (int n = 0; n < 2; ++n) bs[mi][bj][n] = *(const f32x4*)(base + (size_t)(row0 + ai * 128 + (2 * mp + mi) * 16) * DM + col0 + bj * 128 + n * 16);
#pragma unroll
                for (int mi = 0; mi < 2; ++mi)
#pragma unroll
                    for (int bj = 0; bj < 2; ++bj)
#pragma unroll
                        for (int n = 0; n < 2; ++n) { const int m = 2 * mp + mi; *(f32x4*)(out + (size_t)(row0 + ai * 128 + m * 16) * DM + col0 + bj * 128 + n * 16) = bs[mi][bj][n] + gv[bj][n] * acc[ai][bj][m][n]; }
            }
    }
};

template <int MODE> struct EpiResNorm {
    static constexpr bool PERM = false, AFTER_DRAIN = true;
    const float* base; float* out; const float* mod; const float* b_ada; int goff; const float* fg; float* ssq; unsigned* cnt; bf16_t* hb; int sh_off, sc_off;
    DI void operator()(const f32x4 (&)[2][2][4][2], const pg8::Unit&, int, int, int, int) const {}
    DI void fused(f32x4 (&acc)[2][2][4][2], const pg8::Unit& u, int wr, int wc, int fr, int fq, LAS unsigned char* lds, int wid, int lane) const {
        LAS float* P = (LAS float*)lds;
        LAS float* R = P + 1024;
        const int row0 = u.pm * 256 + wr * 64 + fr, col0 = u.pn * 256 + wc * 32 + 4 * fq, b = u.pm >> 3;
        f32x4 gv[2][2];
#pragma unroll
        for (int bj = 0; bj < 2; ++bj)
#pragma unroll
            for (int n = 0; n < 2; ++n) gv[bj][n] = *(const f32x4*)(mod + b * NMOD + goff + col0 + bj * 128 + n * 16) + *(const f32x4*)(b_ada + goff + col0 + bj * 128 + n * 16);
#pragma unroll
        for (int ai = 0; ai < 2; ++ai)
#pragma unroll
            for (int mp = 0; mp < 2; ++mp) {
                f32x4 bs[2][2][2];
#pragma unroll
                for (int mi = 0; mi < 2; ++mi)
#pragma unroll
                    for (int bj = 0; bj < 2; ++bj)
#pragma unroll
                        for (int n = 0; n < 2; ++n) bs[mi][bj][n] = *(const f32x4*)(base + (size_t)(row0 + ai * 128 + (2 * mp + mi) * 16) * DM + col0 + bj * 128 + n * 16);
#pragma unroll
                for (int mi = 0; mi < 2; ++mi) { const int m = 2 * mp + mi; float s = 0.f;
#pragma unroll
                    for (int bj = 0; bj < 2; ++bj)
#pragma unroll
                        for (int n = 0; n < 2; ++n) { const f32x4 x = bs[mi][bj][n] + gv[bj][n] * acc[ai][bj][m][n]; acc[ai][bj][m][n] = x; s += (x[0] * x[0] + x[1] * x[1]) + (x[2] * x[2] + x[3] * x[3]); }
                    s += __shfl_xor(s, 16); s += __shfl_xor(s, 32);
                    if (fq == 0) P[(ai * 128 + wr * 64 + m * 16 + fr) * 4 + wc] = s; }
            }
        __syncthreads();
        const int t = threadIdx.x;
        if (t < 256) { const float s = (P[t * 4] + P[t * 4 + 1]) + (P[t * 4 + 2] + P[t * 4 + 3]);
            __hip_atomic_store(ssq + (size_t)(u.pm * 256 + t) * 8 + u.pn, s, __ATOMIC_RELAXED, __HIP_MEMORY_SCOPE_AGENT); }
        asm volatile("s_waitcnt vmcnt(0)" ::: "memory");
        if (t < 256 && lane == 0) __hip_atomic_fetch_add(cnt + 64 * u.pm, 1u, __ATOMIC_RELAXED, __HIP_MEMORY_SCOPE_AGENT);
        if (wid == 0) {
            unsigned sp = 0;
            while ((unsigned)__builtin_amdgcn_readfirstlane(__hip_atomic_load(cnt + 64 * u.pm, __ATOMIC_RELAXED, __HIP_MEMORY_SCOPE_AGENT)) < 32u) { __builtin_amdgcn_s_sleep(1); if (++sp > (1u << 22)) break; }
            __builtin_amdgcn_fence(__ATOMIC_ACQUIRE, "agent");
            asm volatile("s_waitcnt vmcnt(0)" ::: "memory");
        }
        __syncthreads();
        if (t < 256) { float s = 0.f;
#pragma unroll
            for (int k = 0; k < 8; ++k) s += __hip_atomic_load(ssq + (size_t)(u.pm * 256 + t) * 8 + k, __ATOMIC_RELAXED, __HIP_MEMORY_SCOPE_AGENT);
            R[t] = rsqrtf(s * (1.0f / DM) + EPSN); }
        __syncthreads();
        f32x4 gf[2][2], sh[2][2];
#pragma unroll
        for (int bj = 0; bj < 2; ++bj)
#pragma unroll
            for (int n = 0; n < 2; ++n) { const int c = col0 + bj * 128 + n * 16; gf[bj][n] = *(const f32x4*)(fg + c); sh[bj][n] = (f32x4){0.f, 0.f, 0.f, 0.f};
                if (MODE == 1) { gf[bj][n] *= (*(const f32x4*)(mod + b * NMOD + sc_off + c) + *(const f32x4*)(b_ada + sc_off + c)) + 1.0f; sh[bj][n] = *(const f32x4*)(mod + b * NMOD + sh_off + c) + *(const f32x4*)(b_ada + sh_off + c); } }
#pragma unroll
        for (int ai = 0; ai < 2; ++ai)
#pragma unroll
            for (int m = 0; m < 4; ++m) { const float rs = R[ai * 128 + wr * 64 + m * 16 + fr]; const size_t ro = (size_t)(row0 + ai * 128 + m * 16) * DM + col0;
#pragma unroll
                for (int bj = 0; bj < 2; ++bj)
#pragma unroll
                    for (int n = 0; n < 2; ++n) {
                        if (MODE == 0) *(f32x4*)(out + ro + bj * 128 + n * 16) = (acc[ai][bj][m][n] * rs) * gf[bj][n];
                        else { const f32x4 x = acc[ai][bj][m][n], y = (x * rs) * gf[bj][n] + sh[bj][n]; *(f32x4*)(out + ro + bj * 128 + n * 16) = x;
                               u32x2 w; w.x = pg8::cvt_pk_bf16(y[0], y[1]); w.y = pg8::cvt_pk_bf16(y[2], y[3]); *(u32x2*)(hb + ro + bj * 128 + n * 16) = w; } } }
    }
};
DI void map_tile(int L, int nM, int nN, int& pm, int& pn) {
    const int nwg = nM * nN; int wgid = L; { const int q = nwg / pg8::NXCD, r = nwg % pg8::NXCD, xcd = wgid % pg8::NXCD, off = wgid / pg8::NXCD; wgid = (xcd < r ? xcd * (q + 1) : r * (q + 1) + (xcd - r) * q) + off; }
    const int nig = pg8::WGM * nN, gid = wgid / nig, fm = gid * pg8::WGM, gsz = (nM - fm) < pg8::WGM ? (nM - fm) : pg8::WGM;
    pm = fm + ((wgid % nig) % gsz); pn = (wgid % nig) / gsz;
}
struct SchedRG {
    int G, c;
    DI void init(int G_, int c_) { G = G_; c = c_; }
    DI bool next(int i, pg8::Unit& u) const {
        const int L = i * G + c; if (L >= 512) return false;
        int pm, pn; map_tile(L & 255, 32, 8, pm, pn);
        u.pm = pm + (L >= 256 ? 32 : 0); u.pn = pn + (L >= 256 ? 8 : 0); return true;
    }
    DI void a_ready(const pg8::Unit&) const {}
    DI void done(const pg8::Unit&) const {}
};
struct EpiRG {
    static constexpr bool PERM = true, AFTER_DRAIN = false;
    unsigned char* ws;
    DI void operator()(const f32x4 (&acc)[2][2][4][2], const pg8::Unit& u, int wr, int wc, int fr, int fq) const {
        const bool second = u.pm >= 32; const int pm = u.pm - (second ? 32 : 0), pn = u.pn - (second ? 8 : 0);
        const bf16_t* g1 = (const bf16_t*)(ws + (second ? W_MG : W_MR)); const bf16_t* add = (const bf16_t*)(ws + W_T); bf16_t* O = (bf16_t*)(ws + (second ? W_Z : W_T));
        const int row0 = pm * 256 + wr * 64 + fr, col0 = pn * 256 + wc * 32 + 8 * fq;
#pragma unroll
        for (int ai = 0; ai < 2; ++ai)
#pragma unroll
            for (int mp = 0; mp < 2; ++mp) {
                u32x4 gg[2][2], aa[2][2];
#pragma unroll
                for (int mi = 0; mi < 2; ++mi)
#pragma unroll
                    for (int bj = 0; bj < 2; ++bj) { const size_t ro = (size_t)(row0 + ai * 128 + (2 * mp + mi) * 16) * DM + col0 + bj * 128;
                        gg[mi][bj] = *(const u32x4*)(g1 + ro); aa[mi][bj] = second ? *(const u32x4*)(add + ro) : (u32x4){0u, 0u, 0u, 0u}; }
#pragma unroll
                for (int mi = 0; mi < 2; ++mi)
#pragma unroll
                    for (int bj = 0; bj < 2; ++bj) { const int m = 2 * mp + mi; const size_t ro = (size_t)(row0 + ai * 128 + m * 16) * DM + col0 + bj * 128;
                        f32x4 v0 = acc[ai][bj][m][0], v1 = acc[ai][bj][m][1]; const u32x4 g = gg[mi][bj], a = aa[mi][bj];
                        v0[0] = v0[0] * sigmoidf_(lo16(g.x)) + lo16(a.x); v0[1] = v0[1] * sigmoidf_(hi16(g.x)) + hi16(a.x); v0[2] = v0[2] * sigmoidf_(lo16(g.y)) + lo16(a.y); v0[3] = v0[3] * sigmoidf_(hi16(g.y)) + hi16(a.y);
                        v1[0] = v1[0] * sigmoidf_(lo16(g.z)) + lo16(a.z); v1[1] = v1[1] * sigmoidf_(hi16(g.z)) + hi16(a.z); v1[2] = v1[2] * sigmoidf_(lo16(g.w)) + lo16(a.w); v1[3] = v1[3] * sigmoidf_(hi16(g.w)) + hi16(a.w);
                        u32x4 w; w.x = pg8::cvt_pk_bf16(v0[0], v0[1]); w.y = pg8::cvt_pk_bf16(v0[2], v0[3]); w.z = pg8::cvt_pk_bf16(v1[0], v1[1]); w.w = pg8::cvt_pk_bf16(v1[2], v1[3]);
                        *(u32x4*)(O + ro) = w; }
            }
    }
};
template <class Epi> DI void run_gemm(LAS unsigned char* lds, const bf16_t* A, const bf16_t* Bt, int M, int N, int K, const Epi& E) {
    pg8::Gemm g; g.A = A; g.Bt = Bt; g.M = M; g.N = N; g.K = K;
    pg8::StaticOrder so; so.init(M, N, gridDim.x, blockIdx.x);
    pg8::gemm_phase<Epi, pg8::StaticOrder, false>(lds, g, so, E, nullptr);
}
constexpr int TP = 264;
DI void tile_ld(const bf16_t* __restrict__ src, int ld, LAS bf16_t* T) {
#pragma unroll
    for (int k = 0; k < 4; ++k) { const int i = threadIdx.x + 512 * k, row = i >> 5, pc = i & 31; *(LAS u32x4*)(T + row * TP + pc * 8) = *(const u32x4*)(src + (size_t)row * ld + pc * 8); }
}
DI void tile_st(bf16_t* __restrict__ dst, int ld, const LAS bf16_t* T) {
#pragma unroll
    for (int k = 0; k < 4; ++k) { const int i = threadIdx.x + 512 * k, row = i >> 5, pc = i & 31; *(u32x4*)(dst + (size_t)row * ld + pc * 8) = *(const LAS u32x4*)(T + row * TP + pc * 8); }
}
DI void rope_inplace(const Params& p, bf16_t* rq) {
    const float* tc = (const float*)(p.ws + W_COS); const float* tsn = (const float*)(p.ws + W_SIN);
    for (int i = blockIdx.x * 512 + threadIdx.x; i < LROWS * 128; i += gridDim.x * 512) {
        const int g = i & 15, h = (i >> 4) & 7, row = i >> 7, pos = row & (SEQ - 1);
        bf16_t* a = rq + (size_t)row * 2048 + h * 256 + g * 8;
        const u32x4 v1 = *(const u32x4*)a, v2 = *(const u32x4*)(a + 128);
        const f32x4 c0 = *(const f32x4*)(tc + pos * 128 + g * 8), c1 = *(const f32x4*)(tc + pos * 128 + g * 8 + 4), s0 = *(const f32x4*)(tsn + pos * 128 + g * 8), s1 = *(const f32x4*)(tsn + pos * 128 + g * 8 + 4);
        const float x1[8] = {lo16(v1.x), hi16(v1.x), lo16(v1.y), hi16(v1.y), lo16(v1.z), hi16(v1.z), lo16(v1.w), hi16(v1.w)};
        const float x2[8] = {lo16(v2.x), hi16(v2.x), lo16(v2.y), hi16(v2.y), lo16(v2.z), hi16(v2.z), lo16(v2.w), hi16(v2.w)};
        float y1[8], y2[8];
#pragma unroll
        for (int e = 0; e < 8; ++e) { const float cs = e < 4 ? c0[e] : c1[e - 4], sn = e < 4 ? s0[e] : s1[e - 4]; y1[e] = x1[e] * cs - x2[e] * sn; y2[e] = x2[e] * cs + x1[e] * sn; }
        u32x4 w1, w2; w1.x = pk2(y1[0], y1[1]); w1.y = pk2(y1[2], y1[3]); w1.z = pk2(y1[4], y1[5]); w1.w = pk2(y1[6], y1[7]);
        w2.x = pk2(y2[0], y2[1]); w2.y = pk2(y2[2], y2[3]); w2.z = pk2(y2[4], y2[5]); w2.w = pk2(y2[6], y2[7]);
        *(u32x4*)a = w1; *(u32x4*)(a + 128) = w2;
    }
}
template <int DIR> DI void prep_gla_dir(const Params& p, int ch, int h, int cch, int half, bool lat, LAS const float* ga, LAS bf16_t* Tq, LAS bf16_t* Tk, LAS float* tot) {
    const int col = h * 256 + cch;
    float* cd = (float*)(p.ws + (DIR ? W_CDB : W_CDF));
    float up[16];
#pragma unroll
    for (int r = 0; r < 16; ++r) up[r] = p.gate_up[((size_t)DIR * 16 + r) * 1024 + col];
    const float bias = p.gate_bias[DIR * 1024 + col];
    float bl[32]; float b = 0.f;
#pragma unroll
    for (int e = 0; e < 32; ++e) {
        const int ss = 32 * half + e, t = DIR ? 63 - ss : ss;
        float z = bias;
#pragma unroll
        for (int r = 0; r < 16; ++r) z += ga[t * 16 + r] * up[r];
        b += (fminf(z, 0.f) - __logf(1.0f + __expf(-fabsf(z)))) * 0.0625f;
        bl[e] = b;
    }
    if (half == 0) tot[cch] = b;
    __syncthreads();
    const float off = half ? tot[cch] : 0.f;
#pragma unroll
    for (int e = 0; e < 32; ++e) {
        const int ss = 32 * half + e, t = DIR ? 63 - ss : ss;
        const float bb = bl[e] + off, eb = __expf(bb), ebi = __expf(-bb);
        if (lat) Tq[t * TP + cch] = f2bf(bf2f(Tq[t * TP + cch]) * eb);
        Tk[t * TP + cch] = f2bf(bf2f(Tk[t * TP + cch]) * ebi);
    }
    if (half) cd[ch * 1024 + col] = __expf(b + off);
}
DI void prep_gla(const Params& p, LAS unsigned char* lds) {
    LAS bf16_t* Tq = (LAS bf16_t*)lds; LAS bf16_t* Tk = Tq + 64 * TP; LAS float* ga = (LAS float*)(Tk + 64 * TP); LAS float* tot = ga + 64 * 16;
    const bf16_t* gab = (const bf16_t*)(p.ws + W_GAB);
    for (int it = blockIdx.x; it < 144 * 8; it += gridDim.x) {
        const int ch = it >> 3, h = (it >> 1) & 3, dir = it & 1, tid = threadIdx.x;
        const bool lat = ch < 128;
        __syncthreads();
        if (lat) tile_ld((const bf16_t*)(p.ws + W_GQ) + (size_t)ch * 64 * 1024 + h * 256, 1024, Tq);
        tile_ld((const bf16_t*)(p.ws + W_GK) + (size_t)ch * 64 * 1024 + h * 256, 1024, Tk);
#pragma unroll
        for (int i = 0; i < 2; ++i) { const int e = tid + 512 * i, t = e >> 4, r = e & 15; ga[e] = bf2f(gab[((size_t)ch * 64 + t) * 256 + dir * 16 + r]); }
        __syncthreads();
        if (dir == 0) prep_gla_dir<0>(p, ch, h, tid & 255, tid >> 8, lat, ga, Tq, Tk, tot); else prep_gla_dir<1>(p, ch, h, tid & 255, tid >> 8, lat, ga, Tq, Tk, tot);
        __syncthreads();
        if (lat) tile_st((bf16_t*)(p.ws + (dir ? W_QB : W_QF)) + (size_t)ch * 64 * 1024 + h * 256, 1024, Tq);
        tile_st((bf16_t*)(p.ws + (dir ? W_KB : W_KF)) + (size_t)ch * 64 * 1024 + h * 256, 1024, Tk);
    }
}
#define MFMA16(a, b, c) __builtin_amdgcn_mfma_f32_16x16x32_bf16((a), (b), (c), 0, 0, 0)
constexpr int QP = 264, KTP = 72;
#define GAS __attribute__((address_space(1)))
template <class T> DI GAS T* uni(T* p) { const unsigned long long v = (unsigned long long)p; const unsigned lo = __builtin_amdgcn_readfirstlane((unsigned)v), hi = __builtin_amdgcn_readfirstlane((unsigned)(v >> 32)); return (GAS T*)(((unsigned long long)hi << 32) | lo); }
typedef short s16x4 __attribute__((ext_vector_type(4)));
constexpr int VP = 136;
DI bf16x8 tr_frag(LAS const bf16_t* T, int pitch_b, int k0, int c0, int r, int g) {
    LAS const char* a = (LAS const char*)T + (k0 + 8 * g + (r >> 2)) * pitch_b + c0 * 2 + 8 * (r & 3);
    const s16x4 lo = __builtin_amdgcn_ds_read_tr16_b64_v4i16((LAS s16x4*)a), hi = __builtin_amdgcn_ds_read_tr16_b64_v4i16((LAS s16x4*)(a + 4 * pitch_b));
    return (bf16x8){lo[0], lo[1], lo[2], lo[3], hi[0], hi[1], hi[2], hi[3]};
}
DI void scan_phase(const Params& p, LAS unsigned char* lds) {
    LAS bf16_t* Qs = (LAS bf16_t*)lds; LAS bf16_t* Ks2 = Qs + 64 * QP; LAS bf16_t* Vs = Ks2 + 2 * 64 * QP; LAS bf16_t* Sc = Vs + 64 * VP; LAS float* Cd2 = (LAS float*)(Sc + 64 * KTP);
    const int tid = threadIdx.x, wid = __builtin_amdgcn_readfirstlane(tid >> 6), lane = tid & 63, r = lane & 15, q = lane >> 4, nh = wid >> 2;
    for (int u0 = blockIdx.x; u0 < 256; u0 += gridDim.x) {
        const int u = (u0 & 7) * 32 + (u0 >> 3);
        const bool ret = u < 128; int b, h, dir, part;
        if (ret) { b = u >> 5; h = (u >> 2) & 7; dir = (u >> 1) & 1; part = u & 1; } else { const int v = u - 128; b = v >> 5; h = (v >> 3) & 3; dir = (v >> 2) & 1; part = v & 3; }
        const bf16_t* qb = (const bf16_t*)(p.ws + (ret ? W_RQ : (dir ? W_QB : W_QF))) + h * 256;
        const bf16_t* kb = (const bf16_t*)(p.ws + (ret ? W_RK : (dir ? W_KB : W_KF))) + h * 256;
        const int ldqk = ret ? 2048 : 1024, vcol = ret ? h * 256 + part * 128 : h * 512 + part * 128;
        const bf16_t* vb = (const bf16_t*)(p.ws + (ret ? W_RV : W_GV)) + vcol;
        bf16_t* ob = (ret ? (bf16_t*)(p.ws + (dir ? W_ORB : W_ORF)) : (dir ? (bf16_t*)p.out : (bf16_t*)(p.ws + W_OGF))) + vcol + 16 * wid;
        const unsigned lo_o = (unsigned)(r * 2048 + 4 * q) * 2u;
        const float* cdb = (const float*)(p.ws + (dir ? W_CDB : W_CDF)) + h * 256;
        float c2 = 0.f, g64 = 1.f;
        if (ret) { c2 = logsigmoidf_(p.ret_decay[dir * 8 + h]) * 1.4426950408889634f; g64 = __builtin_amdgcn_exp2f(64.f * c2); }
        float Lv[2], Lo, Uv[8], Uo[4];
#pragma unroll
        for (int s = 0; s < 2; ++s) Lv[s] = __builtin_amdgcn_exp2f((dir ? -(float)(64 - 32 * s - 8 * q) : -(float)(32 * s + 8 * q + 1)) * c2);
        Lo = __builtin_amdgcn_exp2f((dir ? (float)(64 - r) : (float)(r + 1)) * c2);
#pragma unroll
        for (int j = 0; j < 8; ++j) Uv[j] = __uint_as_float(__builtin_amdgcn_readfirstlane(__float_as_uint(__builtin_amdgcn_exp2f((dir ? (float)j : -(float)j) * c2))));
#pragma unroll
        for (int nt = 0; nt < 4; ++nt) Uo[nt] = __uint_as_float(__builtin_amdgcn_readfirstlane(__float_as_uint(__builtin_amdgcn_exp2f((dir ? -(float)(16 * nt) : (float)(16 * nt)) * c2))));
        float UoW[4];
#pragma unroll
        for (int nt = 0; nt < 4; ++nt) UoW[nt] = nh ? Uo[(nt + 2) & 3] : Uo[nt];
        f32x4 S[16];
#pragma unroll
        for (int i = 0; i < 16; ++i) S[i] = (f32x4){0.f, 0.f, 0.f, 0.f};
        u32x4 pK[4], pQ[4], pV[2]; float pCd = 1.f;
        const int rr = tid >> 3, c0 = (tid & 7) * 8;
        const unsigned lo_qk = (unsigned)(rr * ldqk + c0) * 2u, lo_vv = (unsigned)(rr * 2048 + (tid & 7) * 16) * 2u;
#define SCAN_ROW0(st_) (((st_) >= 4) ? b * SEQ + 64 * (dir ? 35 - (st_) : (st_) - 4) : LROWS + b * CTX + 64 * (dir ? 3 - (st_) : (st_)))
#define SCAN_LOAD(st_) do { const int row0n = SCAN_ROW0(st_), cidn = row0n >> 6; \
            GAS const char* kr0 = uni((const char*)(kb + (size_t)row0n * ldqk)); GAS const char* qr0 = uni((const char*)(qb + (size_t)row0n * ldqk)); GAS const char* vr0 = uni((const char*)(vb + (size_t)row0n * 2048)); \
            _Pragma("unroll") for (int i = 0; i < 4; ++i) pK[i] = *(GAS const u32x4*)(kr0 + i * 128 + lo_qk); \
            if ((st_) >= 4) { _Pragma("unroll") for (int i = 0; i < 4; ++i) pQ[i] = *(GAS const u32x4*)(qr0 + i * 128 + lo_qk); } \
            pV[0] = *(GAS const u32x4*)(vr0 + lo_vv); pV[1] = *(GAS const u32x4*)(vr0 + 16 + lo_vv); \
            if (!ret && tid < 256) pCd = cdb[(size_t)cidn * 1024 + tid]; } while (0)
#define SCAN_PUT(st_) do { LAS bf16_t* Kn = Ks2 + ((st_) & 1) * 64 * QP; LAS float* Cn = Cd2 + ((st_) & 1) * 256; \
            _Pragma("unroll") for (int i = 0; i < 4; ++i) *(LAS u32x4*)(Kn + rr * QP + c0 + 64 * i) = pK[i]; \
            if ((st_) >= 4) { _Pragma("unroll") for (int i = 0; i < 4; ++i) *(LAS u32x4*)(Qs + rr * QP + c0 + 64 * i) = pQ[i]; } \
            *(LAS u32x4*)(Vs + rr * VP + (tid & 7) * 16) = pV[0]; *(LAS u32x4*)(Vs + rr * VP + (tid & 7) * 16 + 8) = pV[1]; \
            if (tid < 256) Cn[tid] = ret ? g64 : pCd; } while (0)
        SCAN_LOAD(0);
        __syncthreads();
        SCAN_PUT(0);
        for (int st = 0; st < 36; ++st) {
            const bool lat = st >= 4;
            const int row0 = SCAN_ROW0(st);
            LAS bf16_t* Ks = Ks2 + (st & 1) * 64 * QP; LAS float* Cd = Cd2 + (st & 1) * 256;
            __syncthreads();
            if (st + 1 < 36) SCAN_LOAD(st + 1);
            bf16x8 vf[2];
#pragma unroll
            for (int s = 0; s < 2; ++s) vf[s] = tr_frag(Vs, VP * 2, 32 * s, 16 * wid, r, q);
            if (ret) {
#pragma unroll
                for (int s = 0; s < 2; ++s)
#pragma unroll
                    for (int j = 0; j < 8; ++j) vf[s][j] = (short)f2bf(bf2f((unsigned short)vf[s][j]) * (Lv[s] * Uv[j]));
            }
            f32x4 o[4];
#pragma unroll
            for (int nt = 0; nt < 4; ++nt) o[nt] = (f32x4){0.f, 0.f, 0.f, 0.f};
            if (lat) {
                const int mt = wid & 3;
                f32x4 sc0 = (f32x4){0.f, 0.f, 0.f, 0.f}, sc1 = sc0;
#pragma unroll
                for (int ks = 0; ks < 8; ++ks) {
                    bf16x8 qf[4];
#pragma unroll
                    for (int nt = 0; nt < 4; ++nt) {
                        const int ntv = (nt + 2 * nh) & 3;
                        const u32x2 lo = *(const LAS u32x2*)(Qs + (16 * ntv + r) * QP + 32 * ks + 4 * q), hi = *(const LAS u32x2*)(Qs + (16 * ntv + r) * QP + 32 * ks + 16 + 4 * q);
                        u32x4 aa; aa.x = lo.x; aa.y = lo.y; aa.z = hi.x; aa.w = hi.y; qf[nt] = __builtin_bit_cast(bf16x8, aa);
                    }
                    bf16x8 kf;
                    { const u32x2 lo = *(const LAS u32x2*)(Ks + (16 * mt + r) * QP + 32 * ks + 4 * q), hi = *(const LAS u32x2*)(Ks + (16 * mt + r) * QP + 32 * ks + 16 + 4 * q);
                      u32x4 aa; aa.x = lo.x; aa.y = lo.y; aa.z = hi.x; aa.w = hi.y; kf = __builtin_bit_cast(bf16x8, aa); }
                    sc0 = MFMA16(kf, qf[0], sc0); sc1 = MFMA16(kf, qf[1], sc1);
                    u32x4 sw; sw.x = pk2(S[2 * ks][0], S[2 * ks][1]); sw.y = pk2(S[2 * ks][2], S[2 * ks][3]); sw.z = pk2(S[2 * ks + 1][0], S[2 * ks + 1][1]); sw.w = pk2(S[2 * ks + 1][2], S[2 * ks + 1][3]);
                    const bf16x8 sb = __builtin_bit_cast(bf16x8, sw);
#pragma unroll
                    for (int nt = 0; nt < 4; ++nt) o[nt] = MFMA16(sb, qf[nt], o[nt]);
                }
                {
                    const int m0 = 16 * mt + 4 * q, n0 = 32 * nh + r, n1 = n0 + 16;
#pragma unroll
                    for (int j = 0; j < 4; ++j) { const int m = m0 + j, d0 = dir ? m - n0 : n0 - m, d1 = dir ? m - n1 : n1 - m;
                        sc0[j] = d0 >= 0 ? sc0[j] : 0.f; sc1[j] = d1 >= 0 ? sc1[j] : 0.f; }
                    u32x2 w0, w1; w0.x = pk2(sc0[0], sc0[1]); w0.y = pk2(sc0[2], sc0[3]); w1.x = pk2(sc1[0], sc1[1]); w1.y = pk2(sc1[2], sc1[3]);
                    *(LAS u32x2*)(Sc + n0 * KTP + m0) = w0; *(LAS u32x2*)(Sc + n1 * KTP + m0) = w1;
                }
            }
            __syncthreads();
            if (st + 1 < 36) SCAN_PUT(st + 1);
            if (lat) {
#pragma unroll
                for (int s = 0; s < 2; ++s)
#pragma unroll
                    for (int nt = 0; nt < 4; ++nt) { const int ntv = (nt + 2 * nh) & 3; const bf16x8 a = *(const LAS bf16x8*)(Sc + (16 * ntv + r) * KTP + 32 * s + 8 * q); o[nt] = MFMA16(vf[s], a, o[nt]); }
#pragma unroll
                for (int nt = 0; nt < 4; ++nt) { const int ntv = (nt + 2 * nh) & 3; const float sc = Lo * UoW[nt];
                    u32x2 w; w.x = pk2(o[nt][0] * sc, o[nt][1] * sc); w.y = pk2(o[nt][2] * sc, o[nt][3] * sc);
                    *(GAS u32x2*)(uni((char*)(ob + (size_t)(row0 + 16 * ntv) * 2048)) + lo_o) = w; }
            }
#pragma unroll
            for (int cg = 0; cg < 4; ++cg) {
                bf16x8 af[4][2]; f32x4 cdv[4];
#pragma unroll
                for (int c4 = 0; c4 < 4; ++c4) {
#pragma unroll
                    for (int s = 0; s < 2; ++s) af[c4][s] = tr_frag(Ks, QP * 2, 32 * s, 16 * (4 * cg + c4), r, q);
                    cdv[c4] = *(const LAS f32x4*)(Cd + 16 * (4 * cg + c4) + 4 * q);
                }
                __builtin_amdgcn_sched_barrier(0);
#pragma unroll
                for (int c4 = 0; c4 < 4; ++c4) {
                    const int ct = 4 * cg + c4;
#pragma unroll
                    for (int s = 0; s < 2; ++s) S[ct] = MFMA16(af[c4][s], vf[s], S[ct]);
                }
#pragma unroll
                for (int c4 = 0; c4 < 4; ++c4) S[4 * cg + c4] *= cdv[c4];
            }
        }
    }
}
DI void readout_phase(const Params& p) {
    const bf16_t* orf = (const bf16_t*)(p.ws + W_ORF); const bf16_t* orb = (const bf16_t*)(p.ws + W_ORB); const bf16_t* ogf = (const bf16_t*)(p.ws + W_OGF); const bf16_t* ogb = (const bf16_t*)p.out;
    const bf16_t* rg = (const bf16_t*)(p.ws + W_RG); const bf16_t* gg = (const bf16_t*)(p.ws + W_GG); bf16_t* R = (bf16_t*)(p.ws + W_R); bf16_t* G = (bf16_t*)(p.ws + W_G);
    const int lane = threadIdx.x & 63, gw = blockIdx.x * 8 + (threadIdx.x >> 6), nw = gridDim.x * 8;
    for (int tok = gw; tok < LROWS; tok += nw) {
        {
            u32x2 a[8], bq[8], gt[8];
#pragma unroll
            for (int j = 0; j < 8; ++j) { const size_t off = (size_t)tok * 2048 + j * 256 + 4 * lane; a[j] = *(const u32x2*)(orf + off); bq[j] = *(const u32x2*)(orb + off); gt[j] = *(const u32x2*)(rg + off); }
            f32x4 gnr[8];
#pragma unroll
            for (int j = 0; j < 8; ++j) gnr[j] = *(const f32x4*)(p.ret_g + j * 256 + 4 * lane);
#pragma unroll
            for (int j = 0; j < 8; ++j) {
                float o[4] = {lo16(a[j].x) + lo16(bq[j].x), hi16(a[j].x) + hi16(bq[j].x), lo16(a[j].y) + lo16(bq[j].y), hi16(a[j].y) + hi16(bq[j].y)};
                const float mu = wave_sum(o[0] + o[1] + o[2] + o[3]) * (1.0f / 256.0f);
                float vs = 0.f;
#pragma unroll
                for (int e = 0; e < 4; ++e) { o[e] -= mu; vs += o[e] * o[e]; }
                const float rs = rsqrtf(wave_sum(vs) * (1.0f / 256.0f) + EPSN);
                const f32x4 gn = gnr[j];
                const float g4[4] = {lo16(gt[j].x), hi16(gt[j].x), lo16(gt[j].y), hi16(gt[j].y)};
                float y[4];
#pragma unroll
                for (int e = 0; e < 4; ++e) y[e] = o[e] * rs * gn[e] * siluf_(g4[e]);
                u32x2 w; w.x = pk2(y[0], y[1]); w.y = pk2(y[2], y[3]);
                *(u32x2*)(R + (size_t)tok * 2048 + j * 256 + 4 * lane) = w;
            }
        }
        {
            u32x4 a[4], bq[4], gt[4];
#pragma unroll
            for (int hh = 0; hh < 4; ++hh) { const size_t off = (size_t)tok * 2048 + hh * 512 + 8 * lane; a[hh] = *(const u32x4*)(ogf + off); bq[hh] = *(const u32x4*)(ogb + off); gt[hh] = *(const u32x4*)(gg + off); }
            f32x4 gng[4][2];
#pragma unroll
            for (int hh = 0; hh < 4; ++hh) { gng[hh][0] = *(const f32x4*)(p.gla_g + hh * 512 + 8 * lane); gng[hh][1] = *(const f32x4*)(p.gla_g + hh * 512 + 8 * lane + 4); }
#pragma unroll
            for (int hh = 0; hh < 4; ++hh) {
                float o[8] = {lo16(a[hh].x) + lo16(bq[hh].x), hi16(a[hh].x) + hi16(bq[hh].x), lo16(a[hh].y) + lo16(bq[hh].y), hi16(a[hh].y) + hi16(bq[hh].y), lo16(a[hh].z) + lo16(bq[hh].z), hi16(a[hh].z) + hi16(bq[hh].z), lo16(a[hh].w) + lo16(bq[hh].w), hi16(a[hh].w) + hi16(bq[hh].w)};
                float vs = 0.f;
#pragma unroll
                for (int e = 0; e < 8; ++e) vs += o[e] * o[e];
                const float rs = rsqrtf(wave_sum(vs) * (1.0f / 512.0f) + EPSN);
                const f32x4 gn0 = gng[hh][0], gn1 = gng[hh][1];
                const float g8[8] = {lo16(gt[hh].x), hi16(gt[hh].x), lo16(gt[hh].y), hi16(gt[hh].y), lo16(gt[hh].z), hi16(gt[hh].z), lo16(gt[hh].w), hi16(gt[hh].w)};
                float y[8];
#pragma unroll
                for (int e = 0; e < 8; ++e) y[e] = o[e] * rs * (e < 4 ? gn0[e] : gn1[e - 4]) * siluf_(g8[e]);
                u32x4 w; w.x = pk2(y[0], y[1]); w.y = pk2(y[2], y[3]); w.z = pk2(y[4], y[5]); w.w = pk2(y[6], y[7]);
                *(u32x4*)(G + (size_t)tok * 2048 + hh * 512 + 8 * lane) = w;
            }
        }
    }
}
DI float gelu_tanh(float x) { const float y = 0.7978845608028654f * (x + 0.044715f * x * x * x); const float t = 1.0f - 2.0f * __builtin_amdgcn_rcpf(__expf(2.0f * y) + 1.0f); return 0.5f * x * (1.0f + t); }
DI float dot2bf(unsigned a, unsigned b, float c) { return __builtin_amdgcn_fdot2_f32_bf16(__builtin_bit_cast(bf16x2_t, a), __builtin_bit_cast(bf16x2_t, b), c, false); }
DI void conv_phase(const Params& p) {
    const bf16_t* av = (const bf16_t*)(p.ws + W_AV); bf16_t* U = (bf16_t*)(p.ws + W_U);
    const int per_wg = (NB * 32 * 688 + (int)gridDim.x - 1) / (int)gridDim.x;
    for (int i = blockIdx.x * per_wg + threadIdx.x; i < NB * 32 * 688 && i < (int)(blockIdx.x + 1) * per_wg; i += 512) {
        const int f8 = (i % 688) * 8, br = i / 688, rr = br & 31, b = br >> 5;
        unsigned wlo[3][4], whi[3][4]; float ws[3][8], bias[8];
#pragma unroll
        for (int dc = 0; dc < 3; ++dc) {
            const f32x4 a0 = *(const f32x4*)(p.conv_w + (0 * 3 + dc) * DFF + f8), a1 = *(const f32x4*)(p.conv_w + (0 * 3 + dc) * DFF + f8 + 4);
            const f32x4 b0 = *(const f32x4*)(p.conv_w + (1 * 3 + dc) * DFF + f8), b1 = *(const f32x4*)(p.conv_w + (1 * 3 + dc) * DFF + f8 + 4);
            const f32x4 c0 = *(const f32x4*)(p.conv_w + (2 * 3 + dc) * DFF + f8), c1 = *(const f32x4*)(p.conv_w + (2 * 3 + dc) * DFF + f8 + 4);
            wlo[dc][0] = pk2(a0[0], b0[0]); whi[dc][0] = pk2(a0[1], b0[1]); wlo[dc][1] = pk2(a0[2], b0[2]); whi[dc][1] = pk2(a0[3], b0[3]);
            wlo[dc][2] = pk2(a1[0], b1[0]); whi[dc][2] = pk2(a1[1], b1[1]); wlo[dc][3] = pk2(a1[2], b1[2]); whi[dc][3] = pk2(a1[3], b1[3]);
#pragma unroll
            for (int e = 0; e < 4; ++e) { ws[dc][e] = c0[e]; ws[dc][4 + e] = c1[e]; }
        }
        { const f32x4 c0 = *(const f32x4*)(p.conv_b + f8), c1 = *(const f32x4*)(p.conv_b + f8 + 4);
#pragma unroll
          for (int e = 0; e < 4; ++e) { bias[e] = c0[e]; bias[4 + e] = c1[e]; } }
        const size_t tok0 = (size_t)b * 2048 + rr * 64;
        const bool okm = rr > 0, okp = rr < 31;
        const bf16_t* r0 = av + tok0 * 11008 + f8; const bf16_t* rm = r0 - (size_t)(okm ? 64 : 0) * 11008; const bf16_t* rp = r0 + (size_t)(okp ? 64 : 0) * 11008;
        float acc[3][8];
#pragma unroll
        for (int k = 0; k < 3; ++k)
#pragma unroll
            for (int e = 0; e < 8; ++e) acc[k][e] = bias[e];
        for (int xb = 0; xb < 64; xb += 4) {
            u32x4 am[4], a0[4], ap[4], vv[4];
#pragma unroll
            for (int c = 0; c < 4; ++c) { const size_t o = (size_t)(xb + c) * 11008;
                am[c] = okm ? *(const u32x4*)(rm + o) : (u32x4){0u, 0u, 0u, 0u}; a0[c] = *(const u32x4*)(r0 + o); ap[c] = okp ? *(const u32x4*)(rp + o) : (u32x4){0u, 0u, 0u, 0u};
                const int oc = xb + c - 1; vv[c] = *(const u32x4*)(r0 + (size_t)(oc < 0 ? 0 : oc) * 11008 + DFF); }
            u32x4 outw[4];
#pragma unroll
            for (int c = 0; c < 4; ++c) {
                const unsigned m4[4] = {am[c].x, am[c].y, am[c].z, am[c].w}, z4[4] = {a0[c].x, a0[c].y, a0[c].z, a0[c].w}, p4[4] = {ap[c].x, ap[c].y, ap[c].z, ap[c].w};
                unsigned plo[4], phi[4]; float sg[8];
#pragma unroll
                for (int fp = 0; fp < 4; ++fp) { plo[fp] = (m4[fp] & 0xffffu) | (z4[fp] << 16); phi[fp] = (m4[fp] >> 16) | (z4[fp] & 0xffff0000u); sg[2 * fp] = lo16(p4[fp]); sg[2 * fp + 1] = hi16(p4[fp]); }
#pragma unroll
                for (int dc = 0; dc < 3; ++dc) {
#pragma unroll
                    for (int fp = 0; fp < 4; ++fp) { acc[2 - dc][2 * fp] = dot2bf(plo[fp], wlo[dc][fp], acc[2 - dc][2 * fp]); acc[2 - dc][2 * fp + 1] = dot2bf(phi[fp], whi[dc][fp], acc[2 - dc][2 * fp + 1]); }
#pragma unroll
                    for (int e = 0; e < 8; ++e) acc[2 - dc][e] += sg[e] * ws[dc][e];
                }
                {
                    const u32x4 v = vv[c]; const float v8[8] = {lo16(v.x), hi16(v.x), lo16(v.y), hi16(v.y), lo16(v.z), hi16(v.z), lo16(v.w), hi16(v.w)}; float y[8];
#pragma unroll
                    for (int e = 0; e < 8; ++e) y[e] = gelu_tanh(acc[0][e]) * v8[e];
                    outw[c].x = pk2(y[0], y[1]); outw[c].y = pk2(y[2], y[3]); outw[c].z = pk2(y[4], y[5]); outw[c].w = pk2(y[6], y[7]);
                }
#pragma unroll
                for (int e = 0; e < 8; ++e) { acc[0][e] = acc[1][e]; acc[1][e] = acc[2][e]; acc[2][e] = bias[e]; }
            }
#pragma unroll
            for (int c = 0; c < 4; ++c) { const int oc = xb + c - 1; if (oc >= 0) *(u32x4*)(U + (tok0 + oc) * DFF + f8) = outw[c]; }
        }
        {
            const u32x4 v = *(const u32x4*)(r0 + (size_t)63 * 11008 + DFF); const float v8[8] = {lo16(v.x), hi16(v.x), lo16(v.y), hi16(v.y), lo16(v.z), hi16(v.z), lo16(v.w), hi16(v.w)}; float y[8];
#pragma unroll
            for (int e = 0; e < 8; ++e) y[e] = gelu_tanh(acc[0][e]) * v8[e];
            u32x4 o; o.x = pk2(y[0], y[1]); o.y = pk2(y[2], y[3]); o.z = pk2(y[4], y[5]); o.w = pk2(y[6], y[7]);
            *(u32x4*)(U + (tok0 + 63) * DFF + f8) = o;
        }
    }
}
constexpr int LDS_BYTES = 131072 + 64, NPHASE = 15;
#ifndef REP_IN
#define REP_IN 1
#endif
#ifndef REP0
#define REP0 1
#endif
#ifndef REP4
#define REP4 1
#endif
#ifndef REP6
#define REP6 1
#endif
#ifndef REP12
#define REP12 1
#endif
#ifndef REP9
#define REP9 1
#endif
#ifndef REPN
#define REPN 1
#endif
#ifndef XSYNC
#define XSYNC 0
#endif
#ifndef REP_SCAN
#define REP_SCAN 1
#endif

#define XB_TMO      128
#define XB_XSUB(j)  (1280 + 64 * (j))
#define XB_XGEN(j)  (2304 + 64 * (j))
#define XB_TOP      3328
#define XB_TOPGEN   3392
#define XB_CENS(s_, j) (3456 + 64 * (16 * (s_) + (j)))
#define XB_FLAT     5568
#define XB_PANEL(j) (5632 + 64 * (j))
#define XB_PANEL2(j) (5632 + 64 * 32 + 64 * (j))
#define XB_CONV(j)   (5632 + 64 * 64 + 64 * (j))
#define XB_WORDS    (5632 + 64 * 96)
#define XB_SPIN_CAP (1u << 18)
__device__ unsigned g_xb[XB_WORDS];
DI unsigned xb_ld(unsigned* p)              { return __hip_atomic_load(p, __ATOMIC_RELAXED, __HIP_MEMORY_SCOPE_AGENT); }
DI void     xb_st(unsigned* p, unsigned v)  { __hip_atomic_store(p, v, __ATOMIC_RELAXED, __HIP_MEMORY_SCOPE_AGENT); }
DI unsigned xb_add(unsigned* p, unsigned v) { return __hip_atomic_fetch_add(p, v, __ATOMIC_RELAXED, __HIP_MEMORY_SCOPE_AGENT); }
DI unsigned xb_xcc_id() { return (unsigned)__builtin_amdgcn_s_getreg((3 << 11) | 20) & 0xFu; }
#define XB_SPIN(cond, bar) do { unsigned _sp = 0; while (cond) { __builtin_amdgcn_s_sleep(1); \
    if ((++_sp & 255u) == 0u) { if (xb_ld(&(bar)[XB_TMO])) break; if (_sp > XB_SPIN_CAP) { atomicAdd(&(bar)[XB_TMO], 1u); break; } } } } while (0)
DI void xb_post(volatile LAS unsigned* st) {
    asm volatile("s_waitcnt vmcnt(0)" ::: "memory");
    __syncthreads();
    if (threadIdx.x == 0) {
        unsigned* bar = g_xb; const unsigned G = gridDim.x;
        const unsigned set = (xb_ld(&bar[XB_FLAT]) / G) & 1u, x = xb_xcc_id();
        if (blockIdx.x == 0) {
            for (unsigned j = 0; j < 16; ++j) { xb_st(&bar[XB_CENS(set ^ 1u, j)], 0u); xb_st(&bar[XB_XSUB(j)], 0u); xb_st(&bar[XB_XGEN(j)], 0u); }
            xb_st(&bar[XB_TOP], 0u); xb_st(&bar[XB_TOPGEN], 0u); xb_st(&bar[XB_TMO], 0u);
            for (unsigned j = 0; j < 32; ++j) { xb_st(&bar[XB_PANEL(j)], 0u); xb_st(&bar[XB_PANEL2(j)], 0u); xb_st(&bar[XB_CONV(j)], 0u); }
        }
        xb_add(&bar[XB_CENS(set, x)], 1u);
        __builtin_amdgcn_fence(__ATOMIC_RELEASE, "agent");
        asm volatile("s_waitcnt vmcnt(0)" ::: "memory");
        const unsigned old = xb_add(&bar[XB_FLAT], 1u);
        st[2] = x; st[3] = (old / G + 1u) * G; st[4] = set;
    }
}
DI void xb_wait(volatile LAS unsigned* st) {
    if (threadIdx.x == 0) {
        unsigned* bar = g_xb; const unsigned target = st[3], set = st[4], x = st[2];
        while ((int)(xb_ld(&bar[XB_FLAT]) - target) < 0) __builtin_amdgcn_s_sleep(1);
        __builtin_amdgcn_fence(__ATOMIC_ACQUIRE, "agent");
        asm volatile("s_waitcnt vmcnt(0)" ::: "memory");
        unsigned nloc = 1u, nx = 0u;
        for (unsigned j = 0; j < 16; ++j) { const unsigned c = xb_ld(&bar[XB_CENS(set, j)]); nx += (c > 0u) ? 1u : 0u; nloc = (j == x) ? c : nloc; }
        st[0] = nloc > 0u ? nloc : 1u; st[1] = nx > 0u ? nx : 1u;
    }
    __syncthreads();
}
DI void grid_bar(volatile LAS unsigned* st) {
    asm volatile("s_waitcnt vmcnt(0)" ::: "memory");
    __syncthreads();
    if (threadIdx.x == 0) {
        unsigned* bar = g_xb;
        __builtin_amdgcn_s_waitcnt(0);
        const unsigned nloc = st[0], nx = st[1], x = st[2];
        const unsigned old = xb_add(&bar[XB_XSUB(x)], 1u);
        const unsigned gen = old / nloc;
        if (old + 1u == (gen + 1u) * nloc) {
            __builtin_amdgcn_fence(__ATOMIC_RELEASE, "agent");
            asm volatile("s_waitcnt vmcnt(0)" ::: "memory");
            const unsigned og = xb_add(&bar[XB_TOP], 1u);
            const unsigned tg = og / nx;
            if (og + 1u == (tg + 1u) * nx) xb_add(&bar[XB_TOPGEN], 1u);
            else XB_SPIN(xb_ld(&bar[XB_TOPGEN]) == tg, bar);
            __builtin_amdgcn_fence(__ATOMIC_ACQUIRE, "agent");
            xb_add(&bar[XB_XGEN(x)], 1u);
            asm volatile("s_waitcnt vmcnt(0)" ::: "memory");
        } else {
            XB_SPIN(xb_ld(&bar[XB_XGEN(x)]) == gen, bar);
            __builtin_amdgcn_fence(__ATOMIC_ACQUIRE, "agent");
            asm volatile("s_waitcnt vmcnt(0)" ::: "memory");
        }
    }
    __syncthreads();
}


struct SchedDown : pg8::StaticOrder {
    unsigned* ready;
    DI void a_ready(const pg8::Unit& u) const {
        if (threadIdx.x < 64) {
            unsigned sp = 0;
            while ((unsigned)__builtin_amdgcn_readfirstlane(__hip_atomic_load(ready + 64 * u.pm, __ATOMIC_RELAXED, __HIP_MEMORY_SCOPE_AGENT)) < 8u) { __builtin_amdgcn_s_sleep(1); if (++sp > (1u << 22)) break; }
            __builtin_amdgcn_fence(__ATOMIC_ACQUIRE, "agent");
            asm volatile("s_waitcnt vmcnt(0)" ::: "memory");
        }
        asm volatile("" ::: "memory"); __builtin_amdgcn_s_barrier(); asm volatile("" ::: "memory");
    }
};
__global__ void __launch_bounds__(512, 2) fwd_megakernel(Params p, int ph_lo, int ph_hi) {
    extern __shared__ __attribute__((aligned(16))) unsigned char shm[];
    LAS unsigned char* lds = (LAS unsigned char*)shm;
    cg::grid_group grid = cg::this_grid();
    volatile LAS unsigned* bst = (volatile LAS unsigned*)(lds + 131072);
    unsigned char* ws = p.ws;
    const float* mod = (const float*)(ws + W_MOD);
#define PHASE(k) if ((k) > ph_lo && (k) < ph_hi) { if (ph_hi > 1000) grid.sync(); else grid_bar(bst); } if ((k) >= ph_lo && (k) < ph_hi)
    {
        {
        PHASE(0) {
            ada_phase(p, lds);
            xb_post(bst);
            convert_T<256>(p.w_in, DM, NIN, (bf16_t*)(ws + W_INT), NINP, MapIn(), lds, blockIdx.x, gridDim.x);
            convert_T<256>(p.w_rp, DM, DM, (bf16_t*)(ws + W_RPT), DM, MapPlain(), lds, blockIdx.x, gridDim.x);
            convert_T<256>(p.w_gp, DM, DM, (bf16_t*)(ws + W_GPT), DM, MapPlain(), lds, blockIdx.x, gridDim.x);
            convert_T<256>(p.w_o, DM, DM, (bf16_t*)(ws + W_OT), DM, MapPlain(), lds, blockIdx.x, gridDim.x);
            rope_table(p);
            xb_wait(bst);
            norm_phase<0>(p, TROWS, p.x, p.ctx, p.norm1_g, 0, DM, (bf16_t*)(ws + W_H), nullptr);
        }
        PHASE(3) { { pg8::Gemm g; g.A = (const bf16_t*)(ws + W_H); g.Bt = (const bf16_t*)(ws + W_INT); g.M = TROWS; g.N = NINP; g.K = DM;
                  SchedIn S; S.init(gridDim.x, blockIdx.x); EpiIn E; E.ws = ws;
                  for (int rep = 0; rep < REP_IN; ++rep) pg8::gemm_phase<EpiIn, SchedIn, false>(lds, g, S, E, nullptr);
                  const int G = gridDim.x, U = 32 * 73 + 4 * 29, busy = U - ((U - 1) / G) * G, c = blockIdx.x;
                  if (busy < G) { if (c >= busy) convert_T<256>(p.w_up, DM, 2 * DFF, (bf16_t*)(ws + W_UPT), 2 * DFF, MapPlain(), lds, c - busy, G - busy); }
                  else convert_T<256>(p.w_up, DM, 2 * DFF, (bf16_t*)(ws + W_UPT), 2 * DFF, MapPlain(), lds, c, G); } }
        PHASE(4) {
            for (int rep = 0; rep < REP4; ++rep) prep_gla(p, lds);
            }
        PHASE(5) { for (int rep = 0; rep < REP_SCAN; ++rep) scan_phase(p, lds); }
        PHASE(6) { for (int rep = 0; rep < REP6; ++rep) {
            readout_phase(p);
            } }
        PHASE(7) {
            if (256 % gridDim.x == 0) {
                pg8::Gemm g; g.A = (const bf16_t*)(ws + W_R); g.Bt = (const bf16_t*)(ws + W_RPT); g.M = 2 * LROWS; g.N = 2 * DM; g.K = DM;
                SchedRG S; S.init(gridDim.x, blockIdx.x); EpiRG E; E.ws = ws;
                pg8::gemm_phase<EpiRG, SchedRG, false>(lds, g, S, E, nullptr);
            } else {
                { EpiB<1> E; E.O = (bf16_t*)(ws + W_T); E.ld = DM; E.g1 = (const bf16_t*)(ws + W_MR); E.add = nullptr;
                  run_gemm(lds, (const bf16_t*)(ws + W_R), (const bf16_t*)(ws + W_RPT), LROWS, DM, DM, E); }
                grid_bar(bst);
                { EpiB<2> E; E.O = (bf16_t*)(ws + W_Z); E.ld = DM; E.g1 = (const bf16_t*)(ws + W_MG); E.add = (const bf16_t*)(ws + W_T);
                  run_gemm(lds, (const bf16_t*)(ws + W_G), (const bf16_t*)(ws + W_GPT), LROWS, DM, DM, E); }
            }
        }
        PHASE(9) {
            if (gridDim.x == 256) {
                EpiResNorm<1> E; E.base = p.x; E.out = p.out; E.mod = mod; E.b_ada = p.b_ada; E.goff = 2 * DM; E.fg = p.norm2_g; E.ssq = (float*)(ws + W_SSQ + 256 * 1024); E.cnt = g_xb + XB_PANEL2(0);
                E.hb = (bf16_t*)(ws + W_H2); E.sh_off = 3 * DM; E.sc_off = 4 * DM;
                run_gemm(lds, (const bf16_t*)(ws + W_Z), (const bf16_t*)(ws + W_OT), LROWS, DM, DM, E);
            } else {
                { EpiRes E; E.base = p.x; E.out = p.out; E.mod = mod; E.b_ada = p.b_ada; E.goff = 2 * DM;
                  run_gemm(lds, (const bf16_t*)(ws + W_Z), (const bf16_t*)(ws + W_OT), LROWS, DM, DM, E); }
                grid_bar(bst);
                norm_phase<0>(p, LROWS, p.out, p.out, p.norm2_g, 3 * DM, 4 * DM, (bf16_t*)(ws + W_H2), nullptr);
            }
        }
        PHASE(11) { { EpiB<0> E; E.O = (bf16_t*)(ws + W_AV); E.ld = 2 * DFF; E.g1 = nullptr; E.add = nullptr;
                   run_gemm(lds, (const bf16_t*)(ws + W_H2), (const bf16_t*)(ws + W_UPT), LROWS, 2 * DFF, DM, E);
                   const int G = gridDim.x, U = 32 * 43, busy = U - ((U - 1) / G) * G, c = blockIdx.x;
                   if (busy < G) { if (c >= busy) convert_T<128>(p.w_down, DFF, DM, (bf16_t*)(ws + W_DNT), DM, MapPlain(), lds, c - busy, G - busy); }
                   else convert_T<128>(p.w_down, DFF, DM, (bf16_t*)(ws + W_DNT), DM, MapPlain(), lds, c, G); } }
        PHASE(12) {
            conv_phase(p);
            if (gridDim.x == 256) {
                asm volatile("s_waitcnt vmcnt(0)" ::: "memory");
                __syncthreads();
                if (threadIdx.x == 0) { __builtin_amdgcn_fence(__ATOMIC_RELEASE, "agent"); asm volatile("s_waitcnt vmcnt(0)" ::: "memory"); xb_add(&g_xb[XB_CONV(blockIdx.x >> 3)], 1u); }
                EpiResNorm<0> E; E.base = p.out; E.out = p.out; E.mod = mod; E.b_ada = p.b_ada; E.goff = 5 * DM; E.fg = p.final_g; E.ssq = (float*)(ws + W_SSQ); E.cnt = g_xb + XB_PANEL(0); E.hb = nullptr; E.sh_off = 0; E.sc_off = 0;
                pg8::Gemm g; g.A = (const bf16_t*)(ws + W_U); g.Bt = (const bf16_t*)(ws + W_DNT); g.M = LROWS; g.N = DM; g.K = DFF;
                SchedDown S; S.init(LROWS, DM, gridDim.x, blockIdx.x); S.ready = g_xb + XB_CONV(0);
                pg8::gemm_phase<EpiResNorm<0>, SchedDown, false>(lds, g, S, E, nullptr);
            } else {
                grid_bar(bst);
                EpiRes E; E.base = p.out; E.out = p.out; E.mod = mod; E.b_ada = p.b_ada; E.goff = 5 * DM;
                run_gemm(lds, (const bf16_t*)(ws + W_U), (const bf16_t*)(ws + W_DNT), LROWS, DM, DFF, E);
                grid_bar(bst);
                norm_phase<1>(p, LROWS, p.out, p.out, p.final_g, 0, 0, nullptr, p.out);
            }
        }
        }
    }
}


#ifndef CUT
#define CUT -1
#endif
__global__ void dump_kernel(Params p) {
    const unsigned short* w = (const unsigned short*)p.ws; const size_t n = W_END / 2, N = (size_t)LROWS * DM;
    for (size_t i = (size_t)blockIdx.x * 256 + threadIdx.x; i < N; i += (size_t)gridDim.x * 256) {
        float s = 0.f; for (size_t j = i; j < n; j += N) { const float v = bf2f(w[j]); s += (v == v && fabsf(v) < 1e30f) ? v : 1000.f; }
        p.out[i] = s;
    }
}
extern "C" void kernel_launch(void* const* d_in, const int* in_sizes, int n_in, void* d_out, int out_size, void* d_ws, size_t ws_size, hipStream_t stream) {
    static int grid = 0;
    if (grid == 0) {
        if (n_in != 22 || ws_size < W_END) { fprintf(stderr, "kernel_launch: unexpected inputs (n_in %d, ws %zu, need %zu)\n", n_in, ws_size, (size_t)W_END); grid = -1; return; }
        int dev = 0, cus = 0, per_cu = 0;
        (void)hipGetDevice(&dev); (void)hipDeviceGetAttribute(&cus, hipDeviceAttributeMultiprocessorCount, dev);
        if (hipFuncSetAttribute((const void*)fwd_megakernel, hipFuncAttributeMaxDynamicSharedMemorySize, LDS_BYTES) != hipSuccess) { fprintf(stderr, "hipFuncSetAttribute failed\n"); grid = -1; return; }
        if (hipOccupancyMaxActiveBlocksPerMultiprocessor(&per_cu, (const void*)fwd_megakernel, 512, LDS_BYTES) != hipSuccess || per_cu < 1) { fprintf(stderr, "occupancy query failed (%d)\n", per_cu); per_cu = 1; (void)hipGetLastError(); }
        grid = cus * per_cu;
        if (grid > 256) grid = 256;
    }
    if (grid < 0) return;
    Params p{};
    const float** pp = (const float**)&p;
    for (int i = 0; i < 22; ++i) pp[i] = (const float*)d_in[i];
    p.out = (float*)d_out; p.ws = (unsigned char*)d_ws;
#ifndef NLAUNCH
#define NLAUNCH 1
#endif
    for (int li = 0; li < NLAUNCH; ++li) {
        int lo = NLAUNCH == 1 ? 0 : li, hi = NLAUNCH == 1 ? (CUT >= 0 ? CUT + 1 : NPHASE) : li + 1;
        void* args[] = {&p, &lo, &hi};
        hipError_t e = hipLaunchCooperativeKernel((const void*)fwd_megakernel, dim3(grid), dim3(512), args, LDS_BYTES, stream);
        if (e != hipSuccess) { fprintf(stderr, "cooperative launch failed: %s (grid %d)\n", hipGetErrorString(e), grid); break; }
    }
    if (CUT >= 0) hipLaunchKernelGGL(dump_kernel, dim3(2048), dim3(256), 0, stream, p);
}
```

```cpp
#include <hip/hip_runtime.h>
#include <hip/hip_bf16.h>
#include <hip/hip_cooperative_groups.h>
#include <cstdio>
namespace cg = cooperative_groups;
namespace pg8 {
#define PG8_LAS __attribute__((address_space(3)))
typedef unsigned short bf16_t;
typedef short bf16x8 __attribute__((ext_vector_type(8)));
typedef float f32x4 __attribute__((ext_vector_type(4)));
typedef unsigned u32x4 __attribute__((ext_vector_type(4)));
constexpr int BM = 256, BK = 64, HALF = 128, HTB = HALF * BK * 2  , STAGE_BYTES = 8 * HTB, NXCD = 8, WGM = 8;

__host__ __device__ __forceinline__ int lds_byte(int r, int c) { const int st = (r >> 4) * 2 + (c >> 5), rr = r & 15, cc = c & 31, ob = rr * 64 + cc * 2; return st * 1024 + (ob ^ (((ob >> 9) & 1) << 5)); }
__host__ __device__ __forceinline__ void stage_rc(int b, int& R, int& C) { const int st = b / 1024, sb = b % 1024, swz = sb ^ (((sb >> 9) & 1) << 5); R = (st >> 1) * 16 + swz / 64; C = (st & 1) * 32 + (swz % 64) / 2; }
__host__ __device__ __forceinline__ int perm32(int rho) { const int n = rho >> 4, i = rho & 15; return 8 * (i >> 2) + 4 * n + (i & 3); }

struct Unit { int pm, pn; };
struct Gemm { const bf16_t* A; const bf16_t* Bt; int M, N, K; };

struct StaticOrder {
    int nM, nN, nwg, G, c;
    __host__ __device__ void init(int M, int N, int G_, int c_) { nM = M / BM; nN = N / BM; nwg = nM * nN; G = G_; c = c_; }
    __host__ __device__ bool next(int i, Unit& u) const {
        const long L = (long)i * G + c; if (L >= nwg) return false;
        int wgid = (int)L; { const int q = nwg / NXCD, r = nwg % NXCD, xcd = wgid % NXCD, off = wgid / NXCD; wgid = (xcd < r ? xcd * (q + 1) : r * (q + 1) + (xcd - r) * q) + off; }
        const int nig = WGM * nN, gid = wgid / nig, fm = gid * WGM, gsz = (nM - fm) < WGM ? (nM - fm) : WGM;
        u.pm = fm + ((wgid % nig) % gsz); u.pn = (wgid % nig) / gsz; return true;
    }
    __device__ __forceinline__ void a_ready(const Unit&) const {}
    __device__ __forceinline__ void done(const Unit&) const {}
};
__device__ __forceinline__ unsigned cvt_pk_bf16(float lo, float hi) { unsigned r; asm volatile("v_cvt_pk_bf16_f32 %0, %1, %2" : "=v"(r) : "v"(lo), "v"(hi)); return r; }
typedef float f32x2 __attribute__((ext_vector_type(2)));
__device__ __forceinline__ f32x2 gelu_pk(f32x2 v) {
    const f32x2 av = __builtin_elementwise_abs(v), d = av * 0.2316418882f + 1.0f;
    f32x2 t; t.x = __builtin_amdgcn_rcpf(d.x); t.y = __builtin_amdgcn_rcpf(d.y);
    f32x2 q = t * 0.5307027145f + (-0.7265760135f); q = q * t + 0.7107068705f; q = q * t + (-0.142248368f); q = q * t + 0.127414796f; q = q * t;
    const f32x2 s = (v * v) * (-0.72134752044f);
    f32x2 e; e.x = __builtin_amdgcn_exp2f(s.x); e.y = __builtin_amdgcn_exp2f(s.y);
    const f32x2 m = v * (q * e), r = v - m;
    f32x2 o; o.x = v.x < 0.f ? m.x : r.x; o.y = v.y < 0.f ? m.y : r.y; return o;
}
template <class Epi, class Sched, bool STAMP = false>
__device__ __forceinline__ void gemm_phase(PG8_LAS unsigned char* lds, const Gemm g, const Sched& S, const Epi& E, unsigned long long* stamps) {
    const int tid = threadIdx.x, wid = __builtin_amdgcn_readfirstlane(tid >> 6), lane = tid & 63, wr = wid >> 2, wc = wid & 3, fr = lane & 15, fq = lane >> 4;
    const int K = g.K, nt = K / BK;
    int ts_lo = 0, ts_hi = 0, nts = 0; const unsigned long long rt_entry = STAMP ? (unsigned long long)wall_clock64() : 0ull;
#define PG8_STAMP() do { if (STAMP && wid == 0 && nts < 64) { const unsigned long long _c = (unsigned long long)clock64(); \
        ts_lo = (lane == nts) ? (int)(unsigned)_c : ts_lo; ts_hi = (lane == nts) ? (int)(unsigned)(_c >> 32) : ts_hi; ++nts; } } while (0)
    PG8_STAMP();
    unsigned voffA[2], voffB[2];
#pragma unroll
    for (int i = 0; i < 2; ++i) { int R, C; stage_rc(tid * 16 + i * 8192, R, C); const int Rb = Epi::PERM ? ((R & ~31) + perm32(R & 31)) : R;
        voffA[i] = (unsigned)(R * K + C) * 2u; voffB[i] = (unsigned)(Rb * K + C) * 2u; }
    const size_t kstep = (size_t)(BK * 2);
    const size_t hstep = (size_t)HALF * K * 2;
    const size_t tstep = 2 * hstep;
    const unsigned ldsw = (unsigned)wid * 1024u;
    const int aoff = lds_byte(wr * 64 + fr, fq * 8), boff = lds_byte(wc * 32 + fr, fq * 8);
#define PG8_SA(b, h) (((b) * 2 + (h)) * HTB)
#define PG8_SB(b, h) ((4 + (b) * 2 + (h)) * HTB)
#define PG8_STAGE(bufoff, gbase, voff) do { _Pragma("unroll") for (int _i = 0; _i < 2; ++_i) \
        __builtin_amdgcn_global_load_lds((const unsigned*)((const char*)(gbase) + (voff)[_i]), (PG8_LAS unsigned*)(lds + (bufoff) + ldsw + _i * 8192), 16, 0, 0); } while (0)
#define PG8_LDA(dst, b, h) do { _Pragma("unroll") for (int m = 0; m < 4; ++m) _Pragma("unroll") for (int k = 0; k < 2; ++k) dst[m][k] = *(const PG8_LAS bf16x8*)(lds + PG8_SA(b, h) + aoff + m * 2048 + k * 1024); } while (0)
#define PG8_LDB(dst, b, h) do { _Pragma("unroll") for (int n = 0; n < 2; ++n) _Pragma("unroll") for (int k = 0; k < 2; ++k) dst[n][k] = *(const PG8_LAS bf16x8*)(lds + PG8_SB(b, h) + boff + n * 2048 + k * 1024); } while (0)
#define PG8_MMA(ai, bj, At, Bt) do { __builtin_amdgcn_s_setprio(1); _Pragma("unroll") for (int m = 0; m < 4; ++m) _Pragma("unroll") for (int n = 0; n < 2; ++n) _Pragma("unroll") for (int k = 0; k < 2; ++k) \
        acc[ai][bj][m][n] = __builtin_amdgcn_mfma_f32_16x16x32_bf16(Bt[n][k], At[m][k], acc[ai][bj][m][n], 0, 0, 0); __builtin_amdgcn_s_setprio(0); } while (0)
#define PG8_WAIT_V(n) asm volatile("s_waitcnt vmcnt(" #n ")" ::: "memory")
#define PG8_WAIT_L(n) asm volatile("s_waitcnt lgkmcnt(" #n ")" ::: "memory")
#define PG8_BAR __builtin_amdgcn_s_barrier()
#define PG8_SCHED __builtin_amdgcn_sched_barrier(0)
    Unit cur, nxt; int ui = 0;
    if (!S.next(0, cur)) return;
    f32x4 acc[2][2][4][2];
#pragma unroll
    for (int a = 0; a < 2; ++a)
#pragma unroll
        for (int b = 0; b < 2; ++b)
#pragma unroll
            for (int m = 0; m < 4; ++m)
#pragma unroll
                for (int n = 0; n < 2; ++n) acc[a][b][m][n] = (f32x4){0.f, 0.f, 0.f, 0.f};
    bf16x8 At[4][2], B0[2][2], B1[2][2];
    const char* cA = (const char*)g.A + (size_t)cur.pm * tstep; const char* cB = (const char*)g.Bt + (size_t)cur.pn * tstep;
    S.a_ready(cur);
    PG8_STAGE(PG8_SB(0, 0), cB, voffB); PG8_STAGE(PG8_SA(0, 0), cA, voffA); PG8_STAGE(PG8_SB(0, 1), cB + hstep, voffB); PG8_STAGE(PG8_SA(0, 1), cA + hstep, voffA);
    if (wr == 1) PG8_BAR;
    PG8_WAIT_V(4); PG8_BAR;
    PG8_STAGE(PG8_SB(1, 0), cB + kstep, voffB); PG8_STAGE(PG8_SA(1, 0), cA + kstep, voffA); PG8_STAGE(PG8_SB(1, 1), cB + hstep + kstep, voffB);
    PG8_WAIT_V(6); PG8_BAR;
    PG8_STAMP();
    for (;;) {
        const bool has_next = S.next(ui + 1, nxt);
        const char* nA = has_next ? (const char*)g.A + (size_t)nxt.pm * tstep : cA; const char* nB = has_next ? (const char*)g.Bt + (size_t)nxt.pn * tstep : cB;
        for (int t = 0; t < nt; t += 2) {
            const bool last = (t == nt - 2);
            const char* a1 = cA + (size_t)(t + 1) * kstep;
            const char* a2 = last ? nA : cA + (size_t)(t + 2) * kstep; const char* b2 = last ? nB : cB + (size_t)(t + 2) * kstep;
            const char* a3 = a2 + kstep; const char* b3 = b2 + kstep;
            if (last && has_next) S.a_ready(nxt);
            PG8_LDB(B0, 0, 0); PG8_SCHED; PG8_LDA(At, 0, 0); PG8_STAGE(PG8_SA(1, 1), a1 + hstep, voffA);
            PG8_WAIT_L(8); PG8_BAR; PG8_WAIT_L(0); PG8_MMA(0, 0, At, B0); PG8_BAR; PG8_SCHED;
            PG8_LDB(B1, 0, 1); PG8_STAGE(PG8_SB(0, 0), b2, voffB);
            PG8_BAR; PG8_WAIT_L(0); PG8_MMA(0, 1, At, B1); PG8_BAR;
            PG8_LDA(At, 0, 1); PG8_STAGE(PG8_SA(0, 0), a2, voffA);
            PG8_BAR; PG8_WAIT_L(0); PG8_MMA(1, 0, At, B0); PG8_BAR; PG8_SCHED;
            PG8_STAGE(PG8_SB(0, 1), b2 + hstep, voffB);
            PG8_WAIT_V(6); PG8_BAR; PG8_MMA(1, 1, At, B1); PG8_BAR;
            PG8_LDB(B0, 1, 0); PG8_SCHED; PG8_LDA(At, 1, 0); PG8_STAGE(PG8_SA(0, 1), a2 + hstep, voffA);
            PG8_WAIT_L(8); PG8_BAR; PG8_WAIT_L(0); PG8_MMA(0, 0, At, B0); PG8_BAR; PG8_SCHED;
            PG8_LDB(B1, 1, 1); PG8_STAGE(PG8_SB(1, 0), b3, voffB);
            PG8_BAR; PG8_WAIT_L(0); PG8_MMA(0, 1, At, B1); PG8_BAR;
            PG8_LDA(At, 1, 1); PG8_STAGE(PG8_SA(1, 0), a3, voffA);
            PG8_BAR; PG8_WAIT_L(0); PG8_MMA(1, 0, At, B0); PG8_BAR; PG8_SCHED;
            PG8_STAGE(PG8_SB(1, 1), b3 + hstep, voffB);
            PG8_WAIT_V(6); PG8_BAR; PG8_MMA(1, 1, At, B1); PG8_BAR;
        }
        PG8_STAMP();
        if constexpr (!Epi::AFTER_DRAIN) { E(acc, cur, wr, wc, fr, fq); S.done(cur); }
        PG8_STAMP();
        if (!has_next) break;
#pragma unroll
        for (int a = 0; a < 2; ++a)
#pragma unroll
            for (int b = 0; b < 2; ++b)
#pragma unroll
                for (int m = 0; m < 4; ++m)
#pragma unroll
                    for (int n = 0; n < 2; ++n) acc[a][b][m][n] = (f32x4){0.f, 0.f, 0.f, 0.f};
        cur = nxt; cA = nA; cB = nB; ++ui;
    }
    PG8_WAIT_V(0);
    if (wr == 0) PG8_BAR;
    PG8_BAR;
    if constexpr (Epi::AFTER_DRAIN) { E.fused(acc, cur, wr, wc, fr, fq, lds, wid, lane); S.done(cur); }
    PG8_STAMP();
    if (STAMP && wid == 0) { stamps[lane] = lane < nts ? (((unsigned long long)(unsigned)ts_hi << 32) | (unsigned)ts_lo) : 0ull;
        if (lane == 62) stamps[62] = rt_entry; if (lane == 63) stamps[63] = (unsigned long long)wall_clock64(); }
#undef PG8_STAMP
#undef PG8_SA
#undef PG8_SB
#undef PG8_STAGE
#undef PG8_LDA
#undef PG8_LDB
#undef PG8_MMA
#undef PG8_WAIT_V
#undef PG8_WAIT_L
#undef PG8_BAR
#undef PG8_SCHED
}
}
using pg8::bf16_t; using pg8::bf16x8; using pg8::f32x4; using pg8::u32x4;
typedef unsigned u32x2 __attribute__((ext_vector_type(2)));
#define DI __device__ __forceinline__
#define LAS __attribute__((address_space(3)))

constexpr int DM = 2048, NB = 4, SEQ = 2048, CTX = 256, LROWS = NB * SEQ, TROWS = LROWS + NB * CTX;
constexpr int DFF = 5504, NIN = 18464, NINP = 18688, NMOD = 6 * DM;
constexpr float EPSN = 1e-6f;
constexpr size_t MiB = 1ull << 20;
constexpr size_t W_INT = 0, W_ORF = 0, W_ORB = 32 * MiB;
constexpr size_t W_H = 73 * MiB, W_OGF = 73 * MiB, W_H2 = 73 * MiB;
constexpr size_t W_RPT = 109 * MiB, W_GPT = 117 * MiB, W_OT = 125 * MiB;
constexpr size_t W_MOD = 133 * MiB, W_CDF = W_MOD + 256 * 1024, W_CDB = W_CDF + 640 * 1024, W_COS = 135 * MiB, W_SIN = 136 * MiB;
constexpr size_t W_SSQ = 137 * MiB;
constexpr size_t W_RQ = 138 * MiB, W_RK = 170 * MiB, W_RV = 206 * MiB, W_GQ = 242 * MiB, W_GK = 258 * MiB, W_GV = 276 * MiB,
                 W_RG = 312 * MiB, W_GG = 344 * MiB, W_MR = 376 * MiB, W_MG = 408 * MiB, W_GAB = 440 * MiB;
constexpr size_t W_QF = 444 * MiB + 512 * 1024, W_QB = W_QF + 16 * MiB, W_KF = W_QB + 16 * MiB, W_KB = W_KF + 18 * MiB;
constexpr size_t W_UPT = 512 * MiB + 512 * 1024, W_DNT = W_UPT + 43 * MiB;
constexpr size_t W_R = W_QF, W_G = W_R + 32 * MiB, W_T = W_RQ, W_Z = W_RK;
constexpr size_t W_AV = 138 * MiB, W_U = 312 * MiB;
constexpr size_t W_PART = 548 * MiB + 512 * 1024;
constexpr size_t W_END = 577 * MiB;

struct Params {
    const float *x, *c, *ctx, *c_ctx, *w_ada, *b_ada, *norm1_g, *w_in, *ret_decay, *gate_up, *gate_bias, *ret_g, *gla_g,
                *w_rp, *w_gp, *w_o, *norm2_g, *w_up, *conv_w, *conv_b, *w_down, *final_g;
    float* out; unsigned char* ws;
};

DI float bf2f(unsigned short b) { return __uint_as_float(((unsigned)b) << 16); }
typedef __bf16 bf16x2_t __attribute__((ext_vector_type(2)));
typedef float f32x2_t __attribute__((ext_vector_type(2)));
DI unsigned pk2(float a, float b) { const f32x2_t v = {a, b}; return __builtin_bit_cast(unsigned, __builtin_convertvector(v, bf16x2_t)); }
DI unsigned short f2bf(float a) { return (unsigned short)(pk2(a, 0.f) & 0xffffu); }
DI float lo16(unsigned u) { return __uint_as_float(u << 16); }
DI float hi16(unsigned u) { return __uint_as_float(u & 0xffff0000u); }
DI float sigmoidf_(float x) { return __builtin_amdgcn_rcpf(1.0f + __expf(-x)); }
DI float siluf_(float x) { return x * sigmoidf_(x); }
DI float logsigmoidf_(float x) { return fminf(x, 0.f) - log1pf(expf(-fabsf(x))); }
DI float wave_sum(float v) { for (int o = 32; o >= 1; o >>= 1) v += __shfl_xor(v, o); return v; }

struct MapPlain { DI int src(int n) const { return n; } DI float scale(int) const { return 1.f; } };
struct MapIn {
    DI int src(int n) const { return n < 14336 ? n : (n < 18432 ? n + 32 : (n < 18464 ? n - 18432 + 14336 : -1)); }
    DI float scale(int s) const { return ((s >= 2048 && s < 4096) || (s >= 9216 && s < 10240)) ? 0.0625f : 1.f; }
};
template <int KT, class Map> DI void convert_T(const float* __restrict__ src, int K, int ldsrc, bf16_t* __restrict__ dst, int Nd, Map map, LAS unsigned char* lds, int first, int stride) {
    constexpr int P = KT + 2;
    LAS unsigned short* T = (LAS unsigned short*)lds;
    const int tid = threadIdx.x, nkt = K / KT, ntiles = (Nd / 64) * nkt;
    const int kr = tid >> 4, c4 = tid & 15;
    __syncthreads();
    f32x4 v[KT / 32]; int sc = -1;
#define CVT_LOAD(t_) do { const int n0_ = ((t_) / nkt) * 64, k0_ = ((t_) % nkt) * KT; sc = map.src(n0_ + 4 * c4); \
        _Pragma("unroll") for (int i = 0; i < KT / 32; ++i) { v[i] = (f32x4){0.f, 0.f, 0.f, 0.f}; if (sc >= 0) v[i] = *(const f32x4*)(src + (size_t)(k0_ + kr + 32 * i) * ldsrc + sc); } } while (0)
    if (first < ntiles) CVT_LOAD(first);
    for (int t = first; t < ntiles; t += stride) {
        const int n0 = (t / nkt) * 64, k0 = (t % nkt) * KT;
        const float s = sc >= 0 ? map.scale(sc) : 0.f;
#pragma unroll
        for (int i = 0; i < KT / 32; ++i)
#pragma unroll
            for (int j = 0; j < 4; ++j) T[(4 * c4 + j) * P + kr + 32 * i] = f2bf(v[i][j] * s);
        if (t + stride < ntiles) CVT_LOAD(t + stride);
        __syncthreads();
        const int n = tid >> 3, ks = tid & 7;
#pragma unroll
        for (int i = 0; i < KT / 64; ++i) {
            const LAS unsigned* rp = (const LAS unsigned*)(T + n * P + 8 * ks + 64 * i);
            u32x4 w; w.x = rp[0]; w.y = rp[1]; w.z = rp[2]; w.w = rp[3];
            *(u32x4*)(dst + (size_t)(n0 + n) * K + k0 + 8 * ks + 64 * i) = w;
        }
        __syncthreads();
    }
#undef CVT_LOAD
}
DI void ada_phase(const Params& p, LAS unsigned char* lds) {
    float* mod = (float*)(p.ws + W_MOD);
    LAS float* sl = (LAS float*)lds;
    LAS float* red = sl + 5 * DM;
    __syncthreads();
    for (int i = threadIdx.x; i < 5 * DM; i += 512) { const int v = i >> 11, k = i & (DM - 1); sl[i] = siluf_(v < 4 ? p.c[v * DM + k] : p.c_ctx[k]); }
    __syncthreads();
    const int tid = threadIdx.x, cg4 = tid % 12, rl = tid / 12;
    for (int cb = blockIdx.x; cb < NMOD / 48; cb += gridDim.x) {
        const int n = cb * 48 + 4 * cg4;
        f32x4 acc[5];
#pragma unroll
        for (int v = 0; v < 5; ++v) acc[v] = (f32x4){0.f, 0.f, 0.f, 0.f};
        if (rl < 42) {
            for (int k0 = rl; k0 < DM; k0 += 42 * 7) {
                f32x4 w[7];
#pragma unroll
                for (int i = 0; i < 7; ++i) { const int k = k0 + 42 * i; w[i] = (f32x4){0.f, 0.f, 0.f, 0.f}; if (k < DM) w[i] = *(const f32x4*)(p.w_ada + (size_t)k * NMOD + n); }
#pragma unroll
                for (int i = 0; i < 7; ++i) { const int k = k0 + 42 * i; if (k < DM) {
#pragma unroll
                    for (int v = 0; v < 5; ++v) acc[v] += w[i] * sl[v * DM + k]; } }
            }
#pragma unroll
            for (int v = 0; v < 5; ++v) *(LAS f32x4*)(red + (rl * 12 + cg4) * 20 + 4 * v) = acc[v];
        }
        __syncthreads();
        if (tid < 240) {
            const int g = tid / 20, e = tid % 20; float s = 0.f;
            for (int r2 = 0; r2 < 42; ++r2) s += red[(r2 * 12 + g) * 20 + e];
            mod[(e >> 2) * NMOD + cb * 48 + 4 * g + (e & 3)] = s;
        }
        __syncthreads();
    }
}
DI void rope_table(const Params& p) {
    float* tc = (float*)(p.ws + W_COS); float* ts = (float*)(p.ws + W_SIN);
    for (int i = blockIdx.x * 512 + threadIdx.x; i < SEQ * 128; i += gridDim.x * 512) {
        const int pos = i >> 7, d = i & 127, j = d & 63;
        const float inv = exp2f(-(float)j * (13.287712379549449f / 64.0f));
        const float a = (d < 64 ? (float)(pos >> 6) : (float)(pos & 63)) * inv;
        tc[i] = __cosf(a); ts[i] = __sinf(a);
    }
}
template <int MODE> DI void norm_phase(const Params& p, int nrows, const float* src_lat, const float* src_ctx, const float* gain, int sh_off, int sc_off, bf16_t* outb, float* outf) {
    const float* mod = (const float*)(p.ws + W_MOD);
    const int lane = threadIdx.x & 63, gw = blockIdx.x * 8 + (threadIdx.x >> 6), nw = gridDim.x * 8;
    for (int rowa = gw; rowa < nrows; rowa += 2 * nw) {
        int rows[2] = {rowa, rowa + nw}; const bool has2 = rows[1] < nrows; if (!has2) rows[1] = rowa;
        f32x4 t[2][8]; float ss[2] = {0.f, 0.f};
#pragma unroll
        for (int k = 0; k < 2; ++k) { const int row = rows[k]; const float* s = row < LROWS ? src_lat + (size_t)row * DM : src_ctx + (size_t)(row - LROWS) * DM;
#pragma unroll
            for (int i = 0; i < 8; ++i) t[k][i] = *(const f32x4*)(s + 4 * lane + 256 * i); }
#pragma unroll
        for (int k = 0; k < 2; ++k) {
#pragma unroll
            for (int i = 0; i < 8; ++i) ss[k] += t[k][i][0] * t[k][i][0] + t[k][i][1] * t[k][i][1] + t[k][i][2] * t[k][i][2] + t[k][i][3] * t[k][i][3];
            ss[k] = wave_sum(ss[k]); }
#pragma unroll
        for (int k = 0; k < 2; ++k) {
            if (k == 1 && !has2) break;
            const int row = rows[k], v = row < LROWS ? row / SEQ : 4;
            const float rs = rsqrtf(ss[k] * (1.0f / DM) + EPSN);
#pragma unroll
            for (int i = 0; i < 8; ++i) {
                if (i == 4) __builtin_amdgcn_sched_barrier(0);
                const int col = 4 * lane + 256 * i;
                const f32x4 g = *(const f32x4*)(gain + col);
                if (MODE == 0) {
                    const f32x4 sh = *(const f32x4*)(mod + v * NMOD + sh_off + col) + *(const f32x4*)(p.b_ada + sh_off + col);
                    const f32x4 sc = *(const f32x4*)(mod + v * NMOD + sc_off + col) + *(const f32x4*)(p.b_ada + sc_off + col);
                    t[k][i] = (t[k][i] * rs) * g * (sc + 1.0f) + sh;
                } else t[k][i] = (t[k][i] * rs) * g;
            }
#pragma unroll
            for (int i = 0; i < 8; ++i) {
                const int col = 4 * lane + 256 * i;
                if (MODE == 0) { u32x2 w; w.x = pk2(t[k][i][0], t[k][i][1]); w.y = pk2(t[k][i][2], t[k][i][3]); *(u32x2*)(outb + (size_t)row * DM + col) = w; }
                else *(f32x4*)(outf + (size_t)row * DM + col) = t[k][i];
            }
        }
    }
}
struct SchedIn {
    pg8::StaticOrder so; int G, c;
    DI void init(int G_, int c_) { so.init(LROWS, NINP, G_, c_); G = G_; c = c_; }
    DI bool next(int i, pg8::Unit& u) const {
        const int L = i * G + c;
        if (L < 32 * 73) return so.next(i, u);
        const int j = L - 32 * 73; if (j >= 4 * 29) return false;
        u.pm = 32 + (j & 3); const int q = j >> 2;
        u.pn = q < 8 ? 8 + q : (q < 16 ? 16 + (q - 8) : (q < 20 ? 36 + (q - 16) : (q < 28 ? 40 + (q - 20) : 72)));
        return true;
    }
    DI void a_ready(const pg8::Unit&) const {}
    DI void done(const pg8::Unit&) const {}
};
struct EpiIn {
    static constexpr bool PERM = true, AFTER_DRAIN = false;
    unsigned char* ws;
    DI void operator()(const f32x4 (&acc)[2][2][4][2], const pg8::Unit& u, int wr, int wc, int fr, int fq) const {
        const int pn = u.pn; size_t off; int ld, ct;
        if (pn < 8) { off = W_RQ; ld = 2048; ct = pn; } else if (pn < 16) { off = W_RK; ld = 2048; ct = pn - 8; } else if (pn < 24) { off = W_RV; ld = 2048; ct = pn - 16; }
        else if (pn < 32) { off = W_RG; ld = 2048; ct = pn - 24; } else if (pn < 36) { off = W_GQ; ld = 1024; ct = pn - 32; } else if (pn < 40) { off = W_GK; ld = 1024; ct = pn - 36; }
        else if (pn < 48) { off = W_GV; ld = 2048; ct = pn - 40; } else if (pn < 56) { off = W_GG; ld = 2048; ct = pn - 48; } else if (pn < 64) { off = W_MR; ld = 2048; ct = pn - 56; }
        else if (pn < 72) { off = W_MG; ld = 2048; ct = pn - 64; } else { off = W_GAB; ld = 256; ct = 0; }
        bf16_t* base = (bf16_t*)(ws + off);
        const int row0 = u.pm * 256 + wr * 64 + fr, col0 = ct * 256 + wc * 32 + 8 * fq;
        const bool rope = pn < 16 && u.pm < 32;
        const float* tc = (const float*)(ws + W_COS); const float* tsn = (const float*)(ws + W_SIN);
#pragma unroll
        for (int ai = 0; ai < 2; ++ai)
#pragma unroll
            for (int mp = 0; mp < 2; ++mp) {
                f32x4 cs[2][4];
#pragma unroll
                for (int mi = 0; mi < 2; ++mi) { const int row = row0 + ai * 128 + (2 * mp + mi) * 16, to = (row & (SEQ - 1)) * 128 + wc * 32 + 8 * fq;
                    if (rope) { cs[mi][0] = *(const f32x4*)(tc + to); cs[mi][1] = *(const f32x4*)(tc + to + 4); cs[mi][2] = *(const f32x4*)(tsn + to); cs[mi][3] = *(const f32x4*)(tsn + to + 4); }
                    else { cs[mi][0] = cs[mi][1] = (f32x4){1.f, 1.f, 1.f, 1.f}; cs[mi][2] = cs[mi][3] = (f32x4){0.f, 0.f, 0.f, 0.f}; } }
#pragma unroll
                for (int mi = 0; mi < 2; ++mi) { const int m = 2 * mp + mi, row = row0 + ai * 128 + m * 16; bf16_t* rowp = base + (size_t)row * ld + col0;
                    f32x4 a0 = acc[ai][0][m][0], a1 = acc[ai][0][m][1], b0 = acc[ai][1][m][0], b1 = acc[ai][1][m][1];
                    if (rope) { const f32x4 c0 = cs[mi][0], c1 = cs[mi][1], s0 = cs[mi][2], s1 = cs[mi][3];
                        const f32x4 na0 = a0 * c0 - b0 * s0, nb0 = b0 * c0 + a0 * s0, na1 = a1 * c1 - b1 * s1, nb1 = b1 * c1 + a1 * s1;
                        a0 = na0; b0 = nb0; a1 = na1; b1 = nb1; }
                    u32x4 w; w.x = pg8::cvt_pk_bf16(a0[0], a0[1]); w.y = pg8::cvt_pk_bf16(a0[2], a0[3]); w.z = pg8::cvt_pk_bf16(a1[0], a1[1]); w.w = pg8::cvt_pk_bf16(a1[2], a1[3]);
                    *(u32x4*)rowp = w;
                    w.x = pg8::cvt_pk_bf16(b0[0], b0[1]); w.y = pg8::cvt_pk_bf16(b0[2], b0[3]); w.z = pg8::cvt_pk_bf16(b1[0], b1[1]); w.w = pg8::cvt_pk_bf16(b1[2], b1[3]);
                    *(u32x4*)(rowp + 128) = w; }
            }
    }
};
template <int MODE> struct EpiB {
    static constexpr bool PERM = true, AFTER_DRAIN = false;
    bf16_t* O; int ld; const bf16_t* g1; const bf16_t* add;
    DI void operator()(const f32x4 (&acc)[2][2][4][2], const pg8::Unit& u, int wr, int wc, int fr, int fq) const {
        const int row0 = u.pm * 256 + wr * 64 + fr, col0 = u.pn * 256 + wc * 32 + 8 * fq;
#pragma unroll
        for (int ai = 0; ai < 2; ++ai)
#pragma unroll
            for (int m = 0; m < 4; ++m) { const size_t ro = (size_t)(row0 + ai * 128 + m * 16) * ld + col0;
#pragma unroll
                for (int bj = 0; bj < 2; ++bj) { f32x4 v0 = acc[ai][bj][m][0], v1 = acc[ai][bj][m][1];
                    if (MODE >= 1) { const u32x4 gg = *(const u32x4*)(g1 + ro + bj * 128);
                        v0[0] *= sigmoidf_(lo16(gg.x)); v0[1] *= sigmoidf_(hi16(gg.x)); v0[2] *= sigmoidf_(lo16(gg.y)); v0[3] *= sigmoidf_(hi16(gg.y));
                        v1[0] *= sigmoidf_(lo16(gg.z)); v1[1] *= sigmoidf_(hi16(gg.z)); v1[2] *= sigmoidf_(lo16(gg.w)); v1[3] *= sigmoidf_(hi16(gg.w)); }
                    if (MODE == 2) { const u32x4 aa = *(const u32x4*)(add + ro + bj * 128);
                        v0[0] += lo16(aa.x); v0[1] += hi16(aa.x); v0[2] += lo16(aa.y); v0[3] += hi16(aa.y);
                        v1[0] += lo16(aa.z); v1[1] += hi16(aa.z); v1[2] += lo16(aa.w); v1[3] += hi16(aa.w); }
                    u32x4 w; w.x = pg8::cvt_pk_bf16(v0[0], v0[1]); w.y = pg8::cvt_pk_bf16(v0[2], v0[3]); w.z = pg8::cvt_pk_bf16(v1[0], v1[1]); w.w = pg8::cvt_pk_bf16(v1[2], v1[3]);
                    *(u32x4*)(O + ro + bj * 128) = w; } }
    }
};
struct EpiRes {
    static constexpr bool PERM = false, AFTER_DRAIN = false;
    const float* base; float* out; const float* mod; const float* b_ada; int goff;
    DI void operator()(const f32x4 (&acc)[2][2][4][2], const pg8::Unit& u, int wr, int wc, int fr, int fq) const {
        const int row0 = u.pm * 256 + wr * 64 + fr, col0 = u.pn * 256 + wc * 32 + 4 * fq, b = u.pm >> 3;
        f32x4 gv[2][2];
#pragma unroll
        for (int bj = 0; bj < 2; ++bj)
#pragma unroll
            for (int n = 0; n < 2; ++n) gv[bj][n] = *(const f32x4*)(mod + b * NMOD + goff + col0 + bj * 128 + n * 16) + *(const f32x4*)(b_ada + goff + col0 + bj * 128 + n * 16);
#pragma unroll
        for (int ai = 0; ai < 2; ++ai)
#pragma unroll
            for (int mp = 0; mp < 2; ++mp) {
                f32x4 bs[2][2][2];
#pragma unroll
                for (int mi = 0; mi < 2; ++mi)
#pragma unroll
                    for (int bj = 0; bj < 2; ++bj)
#pragma unroll
                        for (int n = 0; n < 2; ++n) bs[mi][bj][n] = *(const f32x4*)(base + (size_t)(row0 + ai * 128 + (2 * mp + mi) * 16) * DM + col0 + bj * 128 + n * 16);
#pragma unroll
                for (int mi = 0; mi < 2; ++mi)
#pragma unroll
                    for (int bj = 0; bj < 2; ++bj)
#pragma unroll
                        for (int n = 0; n < 2; ++n) { const int m = 2 * mp + mi; *(f32x4*)(out + (size_t)(row0 + ai * 128 + m * 16) * DM + col0 + bj * 128 + n * 16) = bs[mi][bj][n] + gv[bj][n] * acc[ai][bj][m][n]; }
            }
    }
};

template <int MODE> struct EpiResNorm {
    static constexpr bool PERM = false, AFTER_DRAIN = true;
    const float* base; float* out; const float* mod; const float* b_ada; int goff; const float* fg; float* ssq; unsigned* cnt; bf16_t* hb; int sh_off, sc_off;
    DI void operator()(const f32x4 (&)[2][2][4][2], const pg8::Unit&, int, int, int, int) const {}
    DI void fused(f32x4 (&acc)[2][2][4][2], const pg8::Unit& u, int wr, int wc, int fr, int fq, LAS unsigned char* lds, int wid, int lane) const {
        LAS float* P = (LAS float*)lds;
        LAS float* R = P + 1024;
        const int row0 = u.pm * 256 + wr * 64 + fr, col0 = u.pn * 256 + wc * 32 + 4 * fq, b = u.pm >> 3;
        f32x4 gv[2][2];
#pragma unroll
        for (int bj = 0; bj < 2; ++bj)
#pragma unroll
            for (int n = 0; n < 2; ++n) gv[bj][n] = *(const f32x4*)(mod + b * NMOD + goff + col0 + bj * 128 + n * 16) + *(const f32x4*)(b_ada + goff + col0 + bj * 128 + n * 16);
#pragma unroll
        for (int ai = 0; ai < 2; ++ai)
#pragma unroll
            for (int mp = 0; mp < 2; ++mp) {
                f32x4 bs[2][2][2];
#pragma unroll
                for (int mi = 0; mi < 2; ++mi)
#pragma unroll
                    for (int bj = 0; bj < 2; ++bj)
#pragma unroll
                        for (int n = 0; n < 2; ++n) bs[mi][bj][n] = *(const f32x4*)(base + (size_t)(row0 + ai * 128 + (2 * mp + mi) * 16) * DM + col0 + bj * 128 + n * 16);
#pragma unroll
                for (int mi = 0; mi < 2; ++mi) { const int m = 2 * mp + mi; float s = 0.f;
#pragma unroll
                    for (int bj = 0; bj < 2; ++bj)
#pragma unroll
                        for (int n = 0; n < 2; ++n) { const f32x4 x = bs[mi][bj][n] + gv[bj][n] * acc[ai][bj][m][n]; acc[ai][bj][m][n] = x; s += (x[0] * x[0] + x[1] * x[1]) + (x[2] * x[2] + x[3] * x[3]); }
                    s += __shfl_xor(s, 16); s += __shfl_xor(s, 32);
                    if (fq == 0) P[(ai * 128 + wr * 64 + m * 16 + fr) * 4 + wc] = s; }
            }
        __syncthreads();
        const int t = threadIdx.x;
        if (t < 256) { const float s = (P[t * 4] + P[t * 4 + 1]) + (P[t * 4 + 2] + P[t * 4 + 3]);
            __hip_atomic_store(ssq + (size_t)(u.pm * 256 + t) * 8 + u.pn, s, __ATOMIC_RELAXED, __HIP_MEMORY_SCOPE_AGENT); }
        asm volatile("s_waitcnt vmcnt(0)" ::: "memory");
        if (t < 256 && lane == 0) __hip_atomic_fetch_add(cnt + 64 * u.pm, 1u, __ATOMIC_RELAXED, __HIP_MEMORY_SCOPE_AGENT);
        if (wid == 0) {
            unsigned sp = 0;
            while ((unsigned)__builtin_amdgcn_readfirstlane(__hip_atomic_load(cnt + 64 * u.pm, __ATOMIC_RELAXED, __HIP_MEMORY_SCOPE_AGENT)) < 32u) { __builtin_amdgcn_s_sleep(1); if (++sp > (1u << 22)) break; }
            __builtin_amdgcn_fence(__ATOMIC_ACQUIRE, "agent");
            asm volatile("s_waitcnt vmcnt(0)" ::: "memory");
        }
        __syncthreads();
        if (t < 256) { float s = 0.f;
#pragma unroll
            for (int k = 0; k < 8; ++k) s += __hip_atomic_load(ssq + (size_t)(u.pm * 256 + t) * 8 + k, __ATOMIC_RELAXED, __HIP_MEMORY_SCOPE_AGENT);
            R[t] = rsqrtf(s * (1.0f / DM) + EPSN); }
        __syncthreads();
        f32x4 gf[2][2], sh[2][2];
#pragma unroll
        for (int bj = 0; bj < 2; ++bj)
#pragma unroll
            for (int n = 0; n < 2; ++n) { const int c = col0 + bj * 128 + n * 16; gf[bj][n] = *(const f32x4*)(fg + c); sh[bj][n] = (f32x4){0.f, 0.f, 0.f, 0.f};
                if (MODE == 1) { gf[bj][n] *= (*(const f32x4*)(mod + b * NMOD + sc_off + c) + *(const f32x4*)(b_ada + sc_off + c)) + 1.0f; sh[bj][n] = *(const f32x4*)(mod + b * NMOD + sh_off + c) + *(const f32x4*)(b_ada + sh_off + c); } }
#pragma unroll
        for (int ai = 0; ai < 2; ++ai)
#pragma unroll
            for (int m = 0; m < 4; ++m) { const float rs = R[ai * 128 + wr * 64 + m * 16 + fr]; const size_t ro = (size_t)(row0 + ai * 128 + m * 16) * DM + col0;
#pragma unroll
                for (int bj = 0; bj < 2; ++bj)
#pragma unroll
                    for (int n = 0; n < 2; ++n) {
                        if (MODE == 0) *(f32x4*)(out + ro + bj * 128 + n * 16) = (acc[ai][bj][m][n] * rs) * gf[bj][n];
                        else { const f32x4 x = acc[ai][bj][m][n], y = (x * rs) * gf[bj][n] + sh[bj][n]; *(f32x4*)(out + ro + bj * 128 + n * 16) = x;
                               u32x2 w; w.x = pg8::cvt_pk_bf16(y[0], y[1]); w.y = pg8::cvt_pk_bf16(y[2], y[3]); *(u32x2*)(hb + ro + bj * 128 + n * 16) = w; } } }
    }
};
DI void map_tile(int L, int nM, int nN, int& pm, int& pn) {
    const int nwg = nM * nN; int wgid = L; { const int q = nwg / pg8::NXCD, r = nwg % pg8::NXCD, xcd = wgid % pg8::NXCD, off = wgid / pg8::NXCD; wgid = (xcd < r ? xcd * (q + 1) : r * (q + 1) + (xcd - r) * q) + off; }
    const int nig = pg8::WGM * nN, gid = wgid / nig, fm = gid * pg8::WGM, gsz = (nM - fm) < pg8::WGM ? (nM - fm) : pg8::WGM;
    pm = fm + ((wgid % nig) % gsz); pn = (wgid % nig) / gsz;
}
struct SchedRG {
    int G, c;
    DI void init(int G_, int c_) { G = G_; c = c_; }
    DI bool next(int i, pg8::Unit& u) const {
        const int L = i * G + c; if (L >= 512) return false;
        int pm, pn; map_tile(L & 255, 32, 8, pm, pn);
        u.pm = pm + (L >= 256 ? 32 : 0); u.pn = pn + (L >= 256 ? 8 : 0); return true;
    }
    DI void a_ready(const pg8::Unit&) const {}
    DI void done(const pg8::Unit&) const {}
};
struct EpiRG {
    static constexpr bool PERM = true, AFTER_DRAIN = false;
    unsigned char* ws;
    DI void operator()(const f32x4 (&acc)[2][2][4][2], const pg8::Unit& u, int wr, int wc, int fr, int fq) const {
        const bool second = u.pm >= 32; const int pm = u.pm - (second ? 32 : 0), pn = u.pn - (second ? 8 : 0);
        const bf16_t* g1 = (const bf16_t*)(ws + (second ? W_MG : W_MR)); const bf16_t* add = (const bf16_t*)(ws + W_T); bf16_t* O = (bf16_t*)(ws + (second ? W_Z : W_T));
        const int row0 = pm * 256 + wr * 64 + fr, col0 = pn * 256 + wc * 32 + 8 * fq;
#pragma unroll
        for (int ai = 0; ai < 2; ++ai)
#pragma unroll
            for (int mp = 0; mp < 2; ++mp) {
                u32x4 gg[2][2], aa[2][2];
#pragma unroll
                for (int mi = 0; mi < 2; ++mi)
#pragma unroll
                    for (int bj = 0; bj < 2; ++bj) { const size_t ro = (size_t)(row0 + ai * 128 + (2 * mp + mi) * 16) * DM + col0 + bj * 128;
                        gg[mi][bj] = *(const u32x4*)(g1 + ro); aa[mi][bj] = second ? *(const u32x4*)(add + ro) : (u32x4){0u, 0u, 0u, 0u}; }
#pragma unroll
                for (int mi = 0; mi < 2; ++mi)
#pragma unroll
                    for (int bj = 0; bj < 2; ++bj) { const int m = 2 * mp + mi; const size_t ro = (size_t)(row0 + ai * 128 + m * 16) * DM + col0 + bj * 128;
                        f32x4 v0 = acc[ai][bj][m][0], v1 = acc[ai][bj][m][1]; const u32x4 g = gg[mi][bj], a = aa[mi][bj];
                        v0[0] = v0[0] * sigmoidf_(lo16(g.x)) + lo16(a.x); v0[1] = v0[1] * sigmoidf_(hi16(g.x)) + hi16(a.x); v0[2] = v0[2] * sigmoidf_(lo16(g.y)) + lo16(a.y); v0[3] = v0[3] * sigmoidf_(hi16(g.y)) + hi16(a.y);
                        v1[0] = v1[0] * sigmoidf_(lo16(g.z)) + lo16(a.z); v1[1] = v1[1] * sigmoidf_(hi16(g.z)) + hi16(a.z); v1[2] = v1[2] * sigmoidf_(lo16(g.w)) + lo16(a.w); v1[3] = v1[3] * sigmoidf_(hi16(g.w)) + hi16(a.w);
                        u32x4 w; w.x = pg8::cvt_pk_bf16(v0[0], v0[1]); w.y = pg8::cvt_pk_bf16(v0[2], v0[3]); w.z = pg8::cvt_pk_bf16(v1[0], v1[1]); w.w = pg8::cvt_pk_bf16(v1[2], v1[3]);
                        *(u32x4*)(O + ro) = w; }
            }
    }
};
template <class Epi> DI void run_gemm(LAS unsigned char* lds, const bf16_t* A, const bf16_t* Bt, int M, int N, int K, const Epi& E) {
    pg8::Gemm g; g.A = A; g.Bt = Bt; g.M = M; g.N = N; g.K = K;
    pg8::StaticOrder so; so.init(M, N, gridDim.x, blockIdx.x);
    pg8::gemm_phase<Epi, pg8::StaticOrder, false>(lds, g, so, E, nullptr);
}
constexpr int TP = 264;
DI void tile_ld(const bf16_t* __restrict__ src, int ld, LAS bf16_t* T) {
#pragma unroll
    for (int k = 0; k < 4; ++k) { const int i = threadIdx.x + 512 * k, row = i >> 5, pc = i & 31; *(LAS u32x4*)(T + row * TP + pc * 8) = *(const u32x4*)(src + (size_t)row * ld + pc * 8); }
}
DI void tile_st(bf16_t* __restrict__ dst, int ld, const LAS bf16_t* T) {
#pragma unroll
    for (int k = 0; k < 4; ++k) { const int i = threadIdx.x + 512 * k, row = i >> 5, pc = i & 31; *(u32x4*)(dst + (size_t)row * ld + pc * 8) = *(const LAS u32x4*)(T + row * TP + pc * 8); }
}
DI void rope_inplace(const Params& p, bf16_t* rq) {
    const float* tc = (const float*)(p.ws + W_COS); const float* tsn = (const float*)(p.ws + W_SIN);
    for (int i = blockIdx.x * 512 + threadIdx.x; i < LROWS * 128; i += gridDim.x * 512) {
        const int g = i & 15, h = (i >> 4) & 7, row = i >> 7, pos = row & (SEQ - 1);
        bf16_t* a = rq + (size_t)row * 2048 + h * 256 + g * 8;
        const u32x4 v1 = *(const u32x4*)a, v2 = *(const u32x4*)(a + 128);
        const f32x4 c0 = *(const f32x4*)(tc + pos * 128 + g * 8), c1 = *(const f32x4*)(tc + pos * 128 + g * 8 + 4), s0 = *(const f32x4*)(tsn + pos * 128 + g * 8), s1 = *(const f32x4*)(tsn + pos * 128 + g * 8 + 4);
        const float x1[8] = {lo16(v1.x), hi16(v1.x), lo16(v1.y), hi16(v1.y), lo16(v1.z), hi16(v1.z), lo16(v1.w), hi16(v1.w)};
        const float x2[8] = {lo16(v2.x), hi16(v2.x), lo16(v2.y), hi16(v2.y), lo16(v2.z), hi16(v2.z), lo16(v2.w), hi16(v2.w)};
        float y1[8], y2[8];
#pragma unroll
        for (int e = 0; e < 8; ++e) { const float cs = e < 4 ? c0[e] : c1[e - 4], sn = e < 4 ? s0[e] : s1[e - 4]; y1[e] = x1[e] * cs - x2[e] * sn; y2[e] = x2[e] * cs + x1[e] * sn; }
        u32x4 w1, w2; w1.x = pk2(y1[0], y1[1]); w1.y = pk2(y1[2], y1[3]); w1.z = pk2(y1[4], y1[5]); w1.w = pk2(y1[6], y1[7]);
        w2.x = pk2(y2[0], y2[1]); w2.y = pk2(y2[2], y2[3]); w2.z = pk2(y2[4], y2[5]); w2.w = pk2(y2[6], y2[7]);
        *(u32x4*)a = w1; *(u32x4*)(a + 128) = w2;
    }
}
template <int DIR> DI void prep_gla_dir(const Params& p, int ch, int h, int cch, int half, bool lat, LAS const float* ga, LAS bf16_t* Tq, LAS bf16_t* Tk, LAS float* tot) {
    const int col = h * 256 + cch;
    float* cd = (float*)(p.ws + (DIR ? W_CDB : W_CDF));
    float up[16];
#pragma unroll
    for (int r = 0; r < 16; ++r) up[r] = p.gate_up[((size_t)DIR * 16 + r) * 1024 + col];
    const float bias = p.gate_bias[DIR * 1024 + col];
    float bl[32]; float b = 0.f;
#pragma unroll
    for (int e = 0; e < 32; ++e) {
        const int ss = 32 * half + e, t = DIR ? 63 - ss : ss;
        float z = bias;
#pragma unroll
        for (int r = 0; r < 16; ++r) z += ga[t * 16 + r] * up[r];
        b += (fminf(z, 0.f) - __logf(1.0f + __expf(-fabsf(z)))) * 0.0625f;
        bl[e] = b;
    }
    if (half == 0) tot[cch] = b;
    __syncthreads();
    const float off = half ? tot[cch] : 0.f;
#pragma unroll
    for (int e = 0; e < 32; ++e) {
        const int ss = 32 * half + e, t = DIR ? 63 - ss : ss;
        const float bb = bl[e] + off, eb = __expf(bb), ebi = __expf(-bb);
        if (lat) Tq[t * TP + cch] = f2bf(bf2f(Tq[t * TP + cch]) * eb);
        Tk[t * TP + cch] = f2bf(bf2f(Tk[t * TP + cch]) * ebi);
    }
    if (half) cd[ch * 1024 + col] = __expf(b + off);
}
DI void prep_gla(const Params& p, LAS unsigned char* lds) {
    LAS bf16_t* Tq = (LAS bf16_t*)lds; LAS bf16_t* Tk = Tq + 64 * TP; LAS float* ga = (LAS float*)(Tk + 64 * TP); LAS float* tot = ga + 64 * 16;
    const bf16_t* gab = (const bf16_t*)(p.ws + W_GAB);
    for (int it = blockIdx.x; it < 144 * 8; it += gridDim.x) {
        const int ch = it >> 3, h = (it >> 1) & 3, dir = it & 1, tid = threadIdx.x;
        const bool lat = ch < 128;
        __syncthreads();
        if (lat) tile_ld((const bf16_t*)(p.ws + W_GQ) + (size_t)ch * 64 * 1024 + h * 256, 1024, Tq);
        tile_ld((const bf16_t*)(p.ws + W_GK) + (size_t)ch * 64 * 1024 + h * 256, 1024, Tk);
#pragma unroll
        for (int i = 0; i < 2; ++i) { const int e = tid + 512 * i, t = e >> 4, r = e & 15; ga[e] = bf2f(gab[((size_t)ch * 64 + t) * 256 + dir * 16 + r]); }
        __syncthreads();
        if (dir == 0) prep_gla_dir<0>(p, ch, h, tid & 255, tid >> 8, lat, ga, Tq, Tk, tot); else prep_gla_dir<1>(p, ch, h, tid & 255, tid >> 8, lat, ga, Tq, Tk, tot);
        __syncthreads();
        if (lat) tile_st((bf16_t*)(p.ws + (dir ? W_QB : W_QF)) + (size_t)ch * 64 * 1024 + h * 256, 1024, Tq);
        tile_st((bf16_t*)(p.ws + (dir ? W_KB : W_KF)) + (size_t)ch * 64 * 1024 + h * 256, 1024, Tk);
    }
}
#define MFMA16(a, b, c) __builtin_amdgcn_mfma_f32_16x16x32_bf16((a), (b), (c), 0, 0, 0)
constexpr int QP = 264, KTP = 72;
#define GAS __attribute__((address_space(1)))
template <class T> DI GAS T* uni(T* p) { const unsigned long long v = (unsigned long long)p; const unsigned lo = __builtin_amdgcn_readfirstlane((unsigned)v), hi = __builtin_amdgcn_readfirstlane((unsigned)(v >> 32)); return (GAS T*)(((unsigned long long)hi << 32) | lo); }
typedef short s16x4 __attribute__((ext_vector_type(4)));
constexpr int VP = 136;
DI bf16x8 tr_frag(LAS const bf16_t* T, int pitch_b, int k0, int c0, int r, int g) {
    LAS const char* a = (LAS const char*)T + (k0 + 8 * g + (r >> 2)) * pitch_b + c0 * 2 + 8 * (r & 3);
    const s16x4 lo = __builtin_amdgcn_ds_read_tr16_b64_v4i16((LAS s16x4*)a), hi = __builtin_amdgcn_ds_read_tr16_b64_v4i16((LAS s16x4*)(a + 4 * pitch_b));
    return (bf16x8){lo[0], lo[1], lo[2], lo[3], hi[0], hi[1], hi[2], hi[3]};
}
DI void scan_phase(const Params& p, LAS unsigned char* lds) {
    LAS bf16_t* Qs = (LAS bf16_t*)lds; LAS bf16_t* Ks2 = Qs + 64 * QP; LAS bf16_t* Vs = Ks2 + 2 * 64 * QP; LAS bf16_t* Sc = Vs + 64 * VP; LAS float* Cd2 = (LAS float*)(Sc + 64 * KTP);
    const int tid = threadIdx.x, wid = __builtin_amdgcn_readfirstlane(tid >> 6), lane = tid & 63, r = lane & 15, q = lane >> 4, nh = wid >> 2;
    for (int u0 = blockIdx.x; u0 < 256; u0 += gridDim.x) {
        const int u = (u0 & 7) * 32 + (u0 >> 3);
        const bool ret = u < 128; int b, h, dir, part;
        if (ret) { b = u >> 5; h = (u >> 2) & 7; dir = (u >> 1) & 1; part = u & 1; } else { const int v = u - 128; b = v >> 5; h = (v >> 3) & 3; dir = (v >> 2) & 1; part = v & 3; }
        const bf16_t* qb = (const bf16_t*)(p.ws + (ret ? W_RQ : (dir ? W_QB : W_QF))) + h * 256;
        const bf16_t* kb = (const bf16_t*)(p.ws + (ret ? W_RK : (dir ? W_KB : W_KF))) + h * 256;
        const int ldqk = ret ? 2048 : 1024, vcol = ret ? h * 256 + part * 128 : h * 512 + part * 128;
        const bf16_t* vb = (const bf16_t*)(p.ws + (ret ? W_RV : W_GV)) + vcol;
        bf16_t* ob = (ret ? (bf16_t*)(p.ws + (dir ? W_ORB : W_ORF)) : (dir ? (bf16_t*)p.out : (bf16_t*)(p.ws + W_OGF))) + vcol + 16 * wid;
        const unsigned lo_o = (unsigned)(r * 2048 + 4 * q) * 2u;
        const float* cdb = (const float*)(p.ws + (dir ? W_CDB : W_CDF)) + h * 256;
        float c2 = 0.f, g64 = 1.f;
        if (ret) { c2 = logsigmoidf_(p.ret_decay[dir * 8 + h]) * 1.4426950408889634f; g64 = __builtin_amdgcn_exp2f(64.f * c2); }
        float Lv[2], Lo, Uv[8], Uo[4];
#pragma unroll
        for (int s = 0; s < 2; ++s) Lv[s] = __builtin_amdgcn_exp2f((dir ? -(float)(64 - 32 * s - 8 * q) : -(float)(32 * s + 8 * q + 1)) * c2);
        Lo = __builtin_amdgcn_exp2f((dir ? (float)(64 - r) : (float)(r + 1)) * c2);
#pragma unroll
        for (int j = 0; j < 8; ++j) Uv[j] = __uint_as_float(__builtin_amdgcn_readfirstlane(__float_as_uint(__builtin_amdgcn_exp2f((dir ? (float)j : -(float)j) * c2))));
#pragma unroll
        for (int nt = 0; nt < 4; ++nt) Uo[nt] = __uint_as_float(__builtin_amdgcn_readfirstlane(__float_as_uint(__builtin_amdgcn_exp2f((dir ? -(float)(16 * nt) : (float)(16 * nt)) * c2))));
        float UoW[4];
#pragma unroll
        for (int nt = 0; nt < 4; ++nt) UoW[nt] = nh ? Uo[(nt + 2) & 3] : Uo[nt];
        f32x4 S[16];
#pragma unroll
        for (int i = 0; i < 16; ++i) S[i] = (f32x4){0.f, 0.f, 0.f, 0.f};
        u32x4 pK[4], pQ[4], pV[2]; float pCd = 1.f;
        const int rr = tid >> 3, c0 = (tid & 7) * 8;
        const unsigned lo_qk = (unsigned)(rr * ldqk + c0) * 2u, lo_vv = (unsigned)(rr * 2048 + (tid & 7) * 16) * 2u;
#define SCAN_ROW0(st_) (((st_) >= 4) ? b * SEQ + 64 * (dir ? 35 - (st_) : (st_) - 4) : LROWS + b * CTX + 64 * (dir ? 3 - (st_) : (st_)))
#define SCAN_LOAD(st_) do { const int row0n = SCAN_ROW0(st_), cidn = row0n >> 6; \
            GAS const char* kr0 = uni((const char*)(kb + (size_t)row0n * ldqk)); GAS const char* qr0 = uni((const char*)(qb + (size_t)row0n * ldqk)); GAS const char* vr0 = uni((const char*)(vb + (size_t)row0n * 2048)); \
            _Pragma("unroll") for (int i = 0; i < 4; ++i) pK[i] = *(GAS const u32x4*)(kr0 + i * 128 + lo_qk); \
            if ((st_) >= 4) { _Pragma("unroll") for (int i = 0; i < 4; ++i) pQ[i] = *(GAS const u32x4*)(qr0 + i * 128 + lo_qk); } \
            pV[0] = *(GAS const u32x4*)(vr0 + lo_vv); pV[1] = *(GAS const u32x4*)(vr0 + 16 + lo_vv); \
            if (!ret && tid < 256) pCd = cdb[(size_t)cidn * 1024 + tid]; } while (0)
#define SCAN_PUT(st_) do { LAS bf16_t* Kn = Ks2 + ((st_) & 1) * 64 * QP; LAS float* Cn = Cd2 + ((st_) & 1) * 256; \
            _Pragma("unroll") for (int i = 0; i < 4; ++i) *(LAS u32x4*)(Kn + rr * QP + c0 + 64 * i) = pK[i]; \
            if ((st_) >= 4) { _Pragma("unroll") for (int i = 0; i < 4; ++i) *(LAS u32x4*)(Qs + rr * QP + c0 + 64 * i) = pQ[i]; } \
            *(LAS u32x4*)(Vs + rr * VP + (tid & 7) * 16) = pV[0]; *(LAS u32x4*)(Vs + rr * VP + (tid & 7) * 16 + 8) = pV[1]; \
            if (tid < 256) Cn[tid] = ret ? g64 : pCd; } while (0)
        SCAN_LOAD(0);
        __syncthreads();
        SCAN_PUT(0);
        for (int st = 0; st < 36; ++st) {
            const bool lat = st >= 4;
            const int row0 = SCAN_ROW0(st);
            LAS bf16_t* Ks = Ks2 + (st & 1) * 64 * QP; LAS float* Cd = Cd2 + (st & 1) * 256;
            __syncthreads();
            if (st + 1 < 36) SCAN_LOAD(st + 1);
            bf16x8 vf[2];
#pragma unroll
            for (int s = 0; s < 2; ++s) vf[s] = tr_frag(Vs, VP * 2, 32 * s, 16 * wid, r, q);
            if (ret) {
#pragma unroll
                for (int s = 0; s < 2; ++s)
#pragma unroll
                    for (int j = 0; j < 8; ++j) vf[s][j] = (short)f2bf(bf2f((unsigned short)vf[s][j]) * (Lv[s] * Uv[j]));
            }
            f32x4 o[4];
#pragma unroll
            for (int nt = 0; nt < 4; ++nt) o[nt] = (f32x4){0.f, 0.f, 0.f, 0.f};
            if (lat) {
                const int mt = wid & 3;
                f32x4 sc0 = (f32x4){0.f, 0.f, 0.f, 0.f}, sc1 = sc0;
#pragma unroll
                for (int ks = 0; ks < 8; ++ks) {
                    bf16x8 qf[4];
#pragma unroll
                    for (int nt = 0; nt < 4; ++nt) {
                        const int ntv = (nt + 2 * nh) & 3;
                        const u32x2 lo = *(const LAS u32x2*)(Qs + (16 * ntv + r) * QP + 32 * ks + 4 * q), hi = *(const LAS u32x2*)(Qs + (16 * ntv + r) * QP + 32 * ks + 16 + 4 * q);
                        u32x4 aa; aa.x = lo.x; aa.y = lo.y; aa.z = hi.x; aa.w = hi.y; qf[nt] = __builtin_bit_cast(bf16x8, aa);
                    }
                    bf16x8 kf;
                    { const u32x2 lo = *(const LAS u32x2*)(Ks + (16 * mt + r) * QP + 32 * ks + 4 * q), hi = *(const LAS u32x2*)(Ks + (16 * mt + r) * QP + 32 * ks + 16 + 4 * q);
                      u32x4 aa; aa.x = lo.x; aa.y = lo.y; aa.z = hi.x; aa.w = hi.y; kf = __builtin_bit_cast(bf16x8, aa); }
                    sc0 = MFMA16(kf, qf[0], sc0); sc1 = MFMA16(kf, qf[1], sc1);
                    u32x4 sw; sw.x = pk2(S[2 * ks][0], S[2 * ks][1]); sw.y = pk2(S[2 * ks][2], S[2 * ks][3]); sw.z = pk2(S[2 * ks + 1][0], S[2 * ks + 1][1]); sw.w = pk2(S[2 * ks + 1][2], S[2 * ks + 1][3]);
                    const bf16x8 sb = __builtin_bit_cast(bf16x8, sw);
#pragma unroll
                    for (int nt = 0; nt < 4; ++nt) o[nt] = MFMA16(sb, qf[nt], o[nt]);
                }
                {
                    const int m0 = 16 * mt + 4 * q, n0 = 32 * nh + r, n1 = n0 + 16;
#pragma unroll
                    for (int j = 0; j < 4; ++j) { const int m = m0 + j, d0 = dir ? m - n0 : n0 - m, d1 = dir ? m - n1 : n1 - m;
                        sc0[j] = d0 >= 0 ? sc0[j] : 0.f; sc1[j] = d1 >= 0 ? sc1[j] : 0.f; }
                    u32x2 w0, w1; w0.x = pk2(sc0[0], sc0[1]); w0.y = pk2(sc0[2], sc0[3]); w1.x = pk2(sc1[0], sc1[1]); w1.y = pk2(sc1[2], sc1[3]);
                    *(LAS u32x2*)(Sc + n0 * KTP + m0) = w0; *(LAS u32x2*)(Sc + n1 * KTP + m0) = w1;
                }
            }
            __syncthreads();
            if (st + 1 < 36) SCAN_PUT(st + 1);
            if (lat) {
#pragma unroll
                for (int s = 0; s < 2; ++s)
#pragma unroll
                    for (int nt = 0; nt < 4; ++nt) { const int ntv = (nt + 2 * nh) & 3; const bf16x8 a = *(const LAS bf16x8*)(Sc + (16 * ntv + r) * KTP + 32 * s + 8 * q); o[nt] = MFMA16(vf[s], a, o[nt]); }
#pragma unroll
                for (int nt = 0; nt < 4; ++nt) { const int ntv = (nt + 2 * nh) & 3; const float sc = Lo * UoW[nt];
                    u32x2 w; w.x = pk2(o[nt][0] * sc, o[nt][1] * sc); w.y = pk2(o[nt][2] * sc, o[nt][3] * sc);
                    *(GAS u32x2*)(uni((char*)(ob + (size_t)(row0 + 16 * ntv) * 2048)) + lo_o) = w; }
            }
#pragma unroll
            for (int cg = 0; cg < 4; ++cg) {
                bf16x8 af[4][2]; f32x4 cdv[4];
#pragma unroll
                for (int c4 = 0; c4 < 4; ++c4) {
#pragma unroll
                    for (int s = 0; s < 2; ++s) af[c4][s] = tr_frag(Ks, QP * 2, 32 * s, 16 * (4 * cg + c4), r, q);
                    cdv[c4] = *(const LAS f32x4*)(Cd + 16 * (4 * cg + c4) + 4 * q);
                }
                __builtin_amdgcn_sched_barrier(0);
#pragma unroll
                for (int c4 = 0; c4 < 4; ++c4) {
                    const int ct = 4 * cg + c4;
#pragma unroll
                    for (int s = 0; s < 2; ++s) S[ct] = MFMA16(af[c4][s], vf[s], S[ct]);
                }
#pragma unroll
                for (int c4 = 0; c4 < 4; ++c4) S[4 * cg + c4] *= cdv[c4];
            }
        }
    }
}
DI void readout_phase(const Params& p) {
    const bf16_t* orf = (const bf16_t*)(p.ws + W_ORF); const bf16_t* orb = (const bf16_t*)(p.ws + W_ORB); const bf16_t* ogf = (const bf16_t*)(p.ws + W_OGF); const bf16_t* ogb = (const bf16_t*)p.out;
    const bf16_t* rg = (const bf16_t*)(p.ws + W_RG); const bf16_t* gg = (const bf16_t*)(p.ws + W_GG); bf16_t* R = (bf16_t*)(p.ws + W_R); bf16_t* G = (bf16_t*)(p.ws + W_G);
    const int lane = threadIdx.x & 63, gw = blockIdx.x * 8 + (threadIdx.x >> 6), nw = gridDim.x * 8;
    for (int tok = gw; tok < LROWS; tok += nw) {
        {
            u32x2 a[8], bq[8], gt[8];
#pragma unroll
            for (int j = 0; j < 8; ++j) { const size_t off = (size_t)tok * 2048 + j * 256 + 4 * lane; a[j] = *(const u32x2*)(orf + off); bq[j] = *(const u32x2*)(orb + off); gt[j] = *(const u32x2*)(rg + off); }
            f32x4 gnr[8];
#pragma unroll
            for (int j = 0; j < 8; ++j) gnr[j] = *(const f32x4*)(p.ret_g + j * 256 + 4 * lane);
#pragma unroll
            for (int j = 0; j < 8; ++j) {
                float o[4] = {lo16(a[j].x) + lo16(bq[j].x), hi16(a[j].x) + hi16(bq[j].x), lo16(a[j].y) + lo16(bq[j].y), hi16(a[j].y) + hi16(bq[j].y)};
                const float mu = wave_sum(o[0] + o[1] + o[2] + o[3]) * (1.0f / 256.0f);
                float vs = 0.f;
#pragma unroll
                for (int e = 0; e < 4; ++e) { o[e] -= mu; vs += o[e] * o[e]; }
                const float rs = rsqrtf(wave_sum(vs) * (1.0f / 256.0f) + EPSN);
                const f32x4 gn = gnr[j];
                const float g4[4] = {lo16(gt[j].x), hi16(gt[j].x), lo16(gt[j].y), hi16(gt[j].y)};
                float y[4];
#pragma unroll
                for (int e = 0; e < 4; ++e) y[e] = o[e] * rs * gn[e] * siluf_(g4[e]);
                u32x2 w; w.x = pk2(y[0], y[1]); w.y = pk2(y[2], y[3]);
                *(u32x2*)(R + (size_t)tok * 2048 + j * 256 + 4 * lane) = w;
            }
        }
        {
            u32x4 a[4], bq[4], gt[4];
#pragma unroll
            for (int hh = 0; hh < 4; ++hh) { const size_t off = (size_t)tok * 2048 + hh * 512 + 8 * lane; a[hh] = *(const u32x4*)(ogf + off); bq[hh] = *(const u32x4*)(ogb + off); gt[hh] = *(const u32x4*)(gg + off); }
            f32x4 gng[4][2];
#pragma unroll
            for (int hh = 0; hh < 4; ++hh) { gng[hh][0] = *(const f32x4*)(p.gla_g + hh * 512 + 8 * lane); gng[hh][1] = *(const f32x4*)(p.gla_g + hh * 512 + 8 * lane + 4); }
#pragma unroll
            for (int hh = 0; hh < 4; ++hh) {
                float o[8] = {lo16(a[hh].x) + lo16(bq[hh].x), hi16(a[hh].x) + hi16(bq[hh].x), lo16(a[hh].y) + lo16(bq[hh].y), hi16(a[hh].y) + hi16(bq[hh].y), lo16(a[hh].z) + lo16(bq[hh].z), hi16(a[hh].z) + hi16(bq[hh].z), lo16(a[hh].w) + lo16(bq[hh].w), hi16(a[hh].w) + hi16(bq[hh].w)};
                float vs = 0.f;
#pragma unroll
                for (int e = 0; e < 8; ++e) vs += o[e] * o[e];
                const float rs = rsqrtf(wave_sum(vs) * (1.0f / 512.0f) + EPSN);
                const f32x4 gn0 = gng[hh][0], gn1 = gng[hh][1];
                const float g8[8] = {lo16(gt[hh].x), hi16(gt[hh].x), lo16(gt[hh].y), hi16(gt[hh].y), lo16(gt[hh].z), hi16(gt[hh].z), lo16(gt[hh].w), hi16(gt[hh].w)};
                float y[8];
#pragma unroll
                for (int e = 0; e < 8; ++e) y[e] = o[e] * rs * (e < 4 ? gn0[e] : gn1[e - 4]) * siluf_(g8[e]);
                u32x4 w; w.x = pk2(y[0], y[1]); w.y = pk2(y[2], y[3]); w.z = pk2(y[4], y[5]); w.w = pk2(y[6], y[7]);
                *(u32x4*)(G + (size_t)tok * 2048 + hh * 512 + 8 * lane) = w;
            }
        }
    }
}
DI float gelu_tanh(float x) { const float y = 0.7978845608028654f * (x + 0.044715f * x * x * x); const float t = 1.0f - 2.0f * __builtin_amdgcn_rcpf(__expf(2.0f * y) + 1.0f); return 0.5f * x * (1.0f + t); }
DI float dot2bf(unsigned a, unsigned b, float c) { return __builtin_amdgcn_fdot2_f32_bf16(__builtin_bit_cast(bf16x2_t, a), __builtin_bit_cast(bf16x2_t, b), c, false); }
DI void conv_phase(const Params& p) {
    const bf16_t* av = (const bf16_t*)(p.ws + W_AV); bf16_t* U = (bf16_t*)(p.ws + W_U);
    const int per_wg = (NB * 32 * 688 + (int)gridDim.x - 1) / (int)gridDim.x;
    for (int i = blockIdx.x * per_wg + threadIdx.x; i < NB * 32 * 688 && i < (int)(blockIdx.x + 1) * per_wg; i += 512) {
        const int f8 = (i % 688) * 8, br = i / 688, rr = br & 31, b = br >> 5;
        unsigned wlo[3][4], whi[3][4]; float ws[3][8], bias[8];
#pragma unroll
        for (int dc = 0; dc < 3; ++dc) {
            const f32x4 a0 = *(const f32x4*)(p.conv_w + (0 * 3 + dc) * DFF + f8), a1 = *(const f32x4*)(p.conv_w + (0 * 3 + dc) * DFF + f8 + 4);
            const f32x4 b0 = *(const f32x4*)(p.conv_w + (1 * 3 + dc) * DFF + f8), b1 = *(const f32x4*)(p.conv_w + (1 * 3 + dc) * DFF + f8 + 4);
            const f32x4 c0 = *(const f32x4*)(p.conv_w + (2 * 3 + dc) * DFF + f8), c1 = *(const f32x4*)(p.conv_w + (2 * 3 + dc) * DFF + f8 + 4);
            wlo[dc][0] = pk2(a0[0], b0[0]); whi[dc][0] = pk2(a0[1], b0[1]); wlo[dc][1] = pk2(a0[2], b0[2]); whi[dc][1] = pk2(a0[3], b0[3]);
            wlo[dc][2] = pk2(a1[0], b1[0]); whi[dc][2] = pk2(a1[1], b1[1]); wlo[dc][3] = pk2(a1[2], b1[2]); whi[dc][3] = pk2(a1[3], b1[3]);
#pragma unroll
            for (int e = 0; e < 4; ++e) { ws[dc][e] = c0[e]; ws[dc][4 + e] = c1[e]; }
        }
        { const f32x4 c0 = *(const f32x4*)(p.conv_b + f8), c1 = *(const f32x4*)(p.conv_b + f8 + 4);
#pragma unroll
          for (int e = 0; e < 4; ++e) { bias[e] = c0[e]; bias[4 + e] = c1[e]; } }
        const size_t tok0 = (size_t)b * 2048 + rr * 64;
        const bool okm = rr > 0, okp = rr < 31;
        const bf16_t* r0 = av + tok0 * 11008 + f8; const bf16_t* rm = r0 - (size_t)(okm ? 64 : 0) * 11008; const bf16_t* rp = r0 + (size_t)(okp ? 64 : 0) * 11008;
        float acc[3][8];
#pragma unroll
        for (int k = 0; k < 3; ++k)
#pragma unroll
            for (int e = 0; e < 8; ++e) acc[k][e] = bias[e];
        for (int xb = 0; xb < 64; xb += 4) {
            u32x4 am[4], a0[4], ap[4], vv[4];
#pragma unroll
            for (int c = 0; c < 4; ++c) { const size_t o = (size_t)(xb + c) * 11008;
                am[c] = okm ? *(const u32x4*)(rm + o) : (u32x4){0u, 0u, 0u, 0u}; a0[c] = *(const u32x4*)(r0 + o); ap[c] = okp ? *(const u32x4*)(rp + o) : (u32x4){0u, 0u, 0u, 0u};
                const int oc = xb + c - 1; vv[c] = *(const u32x4*)(r0 + (size_t)(oc < 0 ? 0 : oc) * 11008 + DFF); }
            u32x4 outw[4];
#pragma unroll
            for (int c = 0; c < 4; ++c) {
                const unsigned m4[4] = {am[c].x, am[c].y, am[c].z, am[c].w}, z4[4] = {a0[c].x, a0[c].y, a0[c].z, a0[c].w}, p4[4] = {ap[c].x, ap[c].y, ap[c].z, ap[c].w};
                unsigned plo[4], phi[4]; float sg[8];
#pragma unroll
                for (int fp = 0; fp < 4; ++fp) { plo[fp] = (m4[fp] & 0xffffu) | (z4[fp] << 16); phi[fp] = (m4[fp] >> 16) | (z4[fp] & 0xffff0000u); sg[2 * fp] = lo16(p4[fp]); sg[2 * fp + 1] = hi16(p4[fp]); }
#pragma unroll
                for (int dc = 0; dc < 3; ++dc) {
#pragma unroll
                    for (int fp = 0; fp < 4; ++fp) { acc[2 - dc][2 * fp] = dot2bf(plo[fp], wlo[dc][fp], acc[2 - dc][2 * fp]); acc[2 - dc][2 * fp + 1] = dot2bf(phi[fp], whi[dc][fp], acc[2 - dc][2 * fp + 1]); }
#pragma unroll
                    for (int e = 0; e < 8; ++e) acc[2 - dc][e] += sg[e] * ws[dc][e];
                }
                {
                    const u32x4 v = vv[c]; const float v8[8] = {lo16(v.x), hi16(v.x), lo16(v.y), hi16(v.y), lo16(v.z), hi16(v.z), lo16(v.w), hi16(v.w)}; float y[8];
#pragma unroll
                    for (int e = 0; e < 8; ++e) y[e] = gelu_tanh(acc[0][e]) * v8[e];
                    outw[c].x = pk2(y[0], y[1]); outw[c].y = pk2(y[2], y[3]); outw[c].z = pk2(y[4], y[5]); outw[c].w = pk2(y[6], y[7]);
                }
#pragma unroll
                for (int e = 0; e < 8; ++e) { acc[0][e] = acc[1][e]; acc[1][e] = acc[2][e]; acc[2][e] = bias[e]; }
            }
#pragma unroll
            for (int c = 0; c < 4; ++c) { const int oc = xb + c - 1; if (oc >= 0) *(u32x4*)(U + (tok0 + oc) * DFF + f8) = outw[c]; }
        }
        {
            const u32x4 v = *(const u32x4*)(r0 + (size_t)63 * 11008 + DFF); const float v8[8] = {lo16(v.x), hi16(v.x), lo16(v.y), hi16(v.y), lo16(v.z), hi16(v.z), lo16(v.w), hi16(v.w)}; float y[8];
#pragma unroll
            for (int e = 0; e < 8; ++e) y[e] = gelu_tanh(acc[0][e]) * v8[e];
            u32x4 o; o.x = pk2(y[0], y[1]); o.y = pk2(y[2], y[3]); o.z = pk2(y[4], y[5]); o.w = pk2(y[6], y[7]);
            *(u32x4*)(U + (tok0 + 63) * DFF + f8) = o;
        }
    }
}
constexpr int LDS_BYTES = 131072 + 64, NPHASE = 15;
#ifndef REP_IN
#define REP_IN 1
#endif
#ifndef REP0
#define REP0 1
#endif
#ifndef REP4
#define REP4 1
#endif
#ifndef REP6
#define REP6 1
#endif
#ifndef REP12
#define REP12 1
#endif
#ifndef REP9
#define REP9 1
#endif
#ifndef REPN
#define REPN 1
#endif
#ifndef XSYNC
#define XSYNC 0
#endif
#ifndef REP_SCAN
#define REP_SCAN 1
#endif

#define XB_TMO      128
#define XB_XSUB(j)  (1280 + 64 * (j))
#define XB_XGEN(j)  (2304 + 64 * (j))
#define XB_TOP      3328
#define XB_TOPGEN   3392
#define XB_CENS(s_, j) (3456 + 64 * (16 * (s_) + (j)))
#define XB_FLAT     5568
#define XB_PANEL(j) (5632 + 64 * (j))
#define XB_PANEL2(j) (5632 + 64 * 32 + 64 * (j))
#define XB_WORDS    (5632 + 64 * 64)
#define XB_SPIN_CAP (1u << 18)
__device__ unsigned g_xb[XB_WORDS];
DI unsigned xb_ld(unsigned* p)              { return __hip_atomic_load(p, __ATOMIC_RELAXED, __HIP_MEMORY_SCOPE_AGENT); }
DI void     xb_st(unsigned* p, unsigned v)  { __hip_atomic_store(p, v, __ATOMIC_RELAXED, __HIP_MEMORY_SCOPE_AGENT); }
DI unsigned xb_add(unsigned* p, unsigned v) { return __hip_atomic_fetch_add(p, v, __ATOMIC_RELAXED, __HIP_MEMORY_SCOPE_AGENT); }
DI unsigned xb_xcc_id() { return (unsigned)__builtin_amdgcn_s_getreg((3 << 11) | 20) & 0xFu; }
#define XB_SPIN(cond, bar) do { unsigned _sp = 0; while (cond) { __builtin_amdgcn_s_sleep(1); \
    if ((++_sp & 255u) == 0u) { if (xb_ld(&(bar)[XB_TMO])) break; if (_sp > XB_SPIN_CAP) { atomicAdd(&(bar)[XB_TMO], 1u); break; } } } } while (0)
DI void xb_post(volatile LAS unsigned* st) {
    asm volatile("s_waitcnt vmcnt(0)" ::: "memory");
    __syncthreads();
    if (threadIdx.x == 0) {
        unsigned* bar = g_xb; const unsigned G = gridDim.x;
        const unsigned set = (xb_ld(&bar[XB_FLAT]) / G) & 1u, x = xb_xcc_id();
        if (blockIdx.x == 0) {
            for (unsigned j = 0; j < 16; ++j) { xb_st(&bar[XB_CENS(set ^ 1u, j)], 0u); xb_st(&bar[XB_XSUB(j)], 0u); xb_st(&bar[XB_XGEN(j)], 0u); }
            xb_st(&bar[XB_TOP], 0u); xb_st(&bar[XB_TOPGEN], 0u); xb_st(&bar[XB_TMO], 0u);
            for (unsigned j = 0; j < 32; ++j) { xb_st(&bar[XB_PANEL(j)], 0u); xb_st(&bar[XB_PANEL2(j)], 0u); }
        }
        xb_add(&bar[XB_CENS(set, x)], 1u);
        __builtin_amdgcn_fence(__ATOMIC_RELEASE, "agent");
        asm volatile("s_waitcnt vmcnt(0)" ::: "memory");
        const unsigned old = xb_add(&bar[XB_FLAT], 1u);
        st[2] = x; st[3] = (old / G + 1u) * G; st[4] = set;
    }
}
DI void xb_wait(volatile LAS unsigned* st) {
    if (threadIdx.x == 0) {
        unsigned* bar = g_xb; const unsigned target = st[3], set = st[4], x = st[2];
        while ((int)(xb_ld(&bar[XB_FLAT]) - target) < 0) __builtin_amdgcn_s_sleep(1);
        __builtin_amdgcn_fence(__ATOMIC_ACQUIRE, "agent");
        asm volatile("s_waitcnt vmcnt(0)" ::: "memory");
        unsigned nloc = 1u, nx = 0u;
        for (unsigned j = 0; j < 16; ++j) { const unsigned c = xb_ld(&bar[XB_CENS(set, j)]); nx += (c > 0u) ? 1u : 0u; nloc = (j == x) ? c : nloc; }
        st[0] = nloc > 0u ? nloc : 1u; st[1] = nx > 0u ? nx : 1u;
    }
    __syncthreads();
}
DI void grid_bar(volatile LAS unsigned* st) {
    asm volatile("s_waitcnt vmcnt(0)" ::: "memory");
    __syncthreads();
    if (threadIdx.x == 0) {
        unsigned* bar = g_xb;
        __builtin_amdgcn_s_waitcnt(0);
        const unsigned nloc = st[0], nx = st[1], x = st[2];
        const unsigned old = xb_add(&bar[XB_XSUB(x)], 1u);
        const unsigned gen = old / nloc;
        if (old + 1u == (gen + 1u) * nloc) {
            __builtin_amdgcn_fence(__ATOMIC_RELEASE, "agent");
            asm volatile("s_waitcnt vmcnt(0)" ::: "memory");
            const unsigned og = xb_add(&bar[XB_TOP], 1u);
            const unsigned tg = og / nx;
            if (og + 1u == (tg + 1u) * nx) xb_add(&bar[XB_TOPGEN], 1u);
            else XB_SPIN(xb_ld(&bar[XB_TOPGEN]) == tg, bar);
            __builtin_amdgcn_fence(__ATOMIC_ACQUIRE, "agent");
            xb_add(&bar[XB_XGEN(x)], 1u);
            asm volatile("s_waitcnt vmcnt(0)" ::: "memory");
        } else {
            XB_SPIN(xb_ld(&bar[XB_XGEN(x)]) == gen, bar);
            __builtin_amdgcn_fence(__ATOMIC_ACQUIRE, "agent");
            asm volatile("s_waitcnt vmcnt(0)" ::: "memory");
        }
    }
    __syncthreads();
}

__global__ void __launch_bounds__(512, 2) fwd_megakernel(Params p, int ph_lo, int ph_hi) {
    extern __shared__ __attribute__((aligned(16))) unsigned char shm[];
    LAS unsigned char* lds = (LAS unsigned char*)shm;
    cg::grid_group grid = cg::this_grid();
    volatile LAS unsigned* bst = (volatile LAS unsigned*)(lds + 131072);
    unsigned char* ws = p.ws;
    const float* mod = (const float*)(ws + W_MOD);
#define PHASE(k) if ((k) > ph_lo && (k) < ph_hi) { if (ph_hi > 1000) grid.sync(); else grid_bar(bst); } if ((k) >= ph_lo && (k) < ph_hi)
    {
        {
        PHASE(0) {
            ada_phase(p, lds);
            xb_post(bst);
            convert_T<256>(p.w_in, DM, NIN, (bf16_t*)(ws + W_INT), NINP, MapIn(), lds, blockIdx.x, gridDim.x);
            convert_T<256>(p.w_rp, DM, DM, (bf16_t*)(ws + W_RPT), DM, MapPlain(), lds, blockIdx.x, gridDim.x);
            convert_T<256>(p.w_gp, DM, DM, (bf16_t*)(ws + W_GPT), DM, MapPlain(), lds, blockIdx.x, gridDim.x);
            convert_T<256>(p.w_o, DM, DM, (bf16_t*)(ws + W_OT), DM, MapPlain(), lds, blockIdx.x, gridDim.x);
            rope_table(p);
            xb_wait(bst);
            norm_phase<0>(p, TROWS, p.x, p.ctx, p.norm1_g, 0, DM, (bf16_t*)(ws + W_H), nullptr);
        }
        PHASE(3) { { pg8::Gemm g; g.A = (const bf16_t*)(ws + W_H); g.Bt = (const bf16_t*)(ws + W_INT); g.M = TROWS; g.N = NINP; g.K = DM;
                  SchedIn S; S.init(gridDim.x, blockIdx.x); EpiIn E; E.ws = ws;
                  for (int rep = 0; rep < REP_IN; ++rep) pg8::gemm_phase<EpiIn, SchedIn, false>(lds, g, S, E, nullptr);
                  const int G = gridDim.x, U = 32 * 73 + 4 * 29, busy = U - ((U - 1) / G) * G, c = blockIdx.x;
                  if (busy < G) { if (c >= busy) convert_T<256>(p.w_up, DM, 2 * DFF, (bf16_t*)(ws + W_UPT), 2 * DFF, MapPlain(), lds, c - busy, G - busy); }
                  else convert_T<256>(p.w_up, DM, 2 * DFF, (bf16_t*)(ws + W_UPT), 2 * DFF, MapPlain(), lds, c, G); } }
        PHASE(4) {
            for (int rep = 0; rep < REP4; ++rep) prep_gla(p, lds);
            }
        PHASE(5) { for (int rep = 0; rep < REP_SCAN; ++rep) scan_phase(p, lds); }
        PHASE(6) { for (int rep = 0; rep < REP6; ++rep) {
            readout_phase(p);
            } }
        PHASE(7) {
            if (256 % gridDim.x == 0) {
                pg8::Gemm g; g.A = (const bf16_t*)(ws + W_R); g.Bt = (const bf16_t*)(ws + W_RPT); g.M = 2 * LROWS; g.N = 2 * DM; g.K = DM;
                SchedRG S; S.init(gridDim.x, blockIdx.x); EpiRG E; E.ws = ws;
                pg8::gemm_phase<EpiRG, SchedRG, false>(lds, g, S, E, nullptr);
            } else {
                { EpiB<1> E; E.O = (bf16_t*)(ws + W_T); E.ld = DM; E.g1 = (const bf16_t*)(ws + W_MR); E.add = nullptr;
                  run_gemm(lds, (const bf16_t*)(ws + W_R), (const bf16_t*)(ws + W_RPT), LROWS, DM, DM, E); }
                grid_bar(bst);
                { EpiB<2> E; E.O = (bf16_t*)(ws + W_Z); E.ld = DM; E.g1 = (const bf16_t*)(ws + W_MG); E.add = (const bf16_t*)(ws + W_T);
                  run_gemm(lds, (const bf16_t*)(ws + W_G), (const bf16_t*)(ws + W_GPT), LROWS, DM, DM, E); }
            }
        }
        PHASE(9) {
            if (gridDim.x == 256) {
                EpiResNorm<1> E; E.base = p.x; E.out = p.out; E.mod = mod; E.b_ada = p.b_ada; E.goff = 2 * DM; E.fg = p.norm2_g; E.ssq = (float*)(ws + W_SSQ + 256 * 1024); E.cnt = g_xb + XB_PANEL2(0);
                E.hb = (bf16_t*)(ws + W_H2); E.sh_off = 3 * DM; E.sc_off = 4 * DM;
                run_gemm(lds, (const bf16_t*)(ws + W_Z), (const bf16_t*)(ws + W_OT), LROWS, DM, DM, E);
            } else {
                { EpiRes E; E.base = p.x; E.out = p.out; E.mod = mod; E.b_ada = p.b_ada; E.goff = 2 * DM;
                  run_gemm(lds, (const bf16_t*)(ws + W_Z), (const bf16_t*)(ws + W_OT), LROWS, DM, DM, E); }
                grid_bar(bst);
                norm_phase<0>(p, LROWS, p.out, p.out, p.norm2_g, 3 * DM, 4 * DM, (bf16_t*)(ws + W_H2), nullptr);
            }
        }
        PHASE(11) { { EpiB<0> E; E.O = (bf16_t*)(ws + W_AV); E.ld = 2 * DFF; E.g1 = nullptr; E.add = nullptr;
                   run_gemm(lds, (const bf16_t*)(ws + W_H2), (const bf16_t*)(ws + W_UPT), LROWS, 2 * DFF, DM, E);
                   const int G = gridDim.x, U = 32 * 43, busy = U - ((U - 1) / G) * G, c = blockIdx.x;
                   if (busy < G) { if (c >= busy) convert_T<128>(p.w_down, DFF, DM, (bf16_t*)(ws + W_DNT), DM, MapPlain(), lds, c - busy, G - busy); }
                   else convert_T<128>(p.w_down, DFF, DM, (bf16_t*)(ws + W_DNT), DM, MapPlain(), lds, c, G); } }
        PHASE(12) { for (int rep = 0; rep < REP12; ++rep) conv_phase(p); }
        PHASE(13) {
            if (gridDim.x == 256) {
                EpiResNorm<0> E; E.base = p.out; E.out = p.out; E.mod = mod; E.b_ada = p.b_ada; E.goff = 5 * DM; E.fg = p.final_g; E.ssq = (float*)(ws + W_SSQ); E.cnt = g_xb + XB_PANEL(0); E.hb = nullptr; E.sh_off = 0; E.sc_off = 0;
                run_gemm(lds, (const bf16_t*)(ws + W_U), (const bf16_t*)(ws + W_DNT), LROWS, DM, DFF, E);
            } else {
                EpiRes E; E.base = p.out; E.out = p.out; E.mod = mod; E.b_ada = p.b_ada; E.goff = 5 * DM;
                run_gemm(lds, (const bf16_t*)(ws + W_U), (const bf16_t*)(ws + W_DNT), LROWS, DM, DFF, E);
                grid_bar(bst);
                norm_phase<1>(p, LROWS, p.out, p.out, p.final_g, 0, 0, nullptr, p.out);
            }
        }
        }
    }
}


#ifndef CUT
#define CUT -1
#endif
__global__ void dump_kernel(Params p) {
    const unsigned short* w = (const unsigned short*)p.ws; const size_t n = W_END / 2, N = (size_t)LROWS * DM;
    for (size_t i = (size_t)blockIdx.x * 256 + threadIdx.x; i < N; i += (size_t)gridDim.x * 256) {
        float s = 0.f; for (size_t j = i; j < n; j += N) { const float v = bf2f(w[j]); s += (v == v && fabsf(v) < 1e30f) ? v : 1000.f; }
        p.out[i] = s;
    }
}
extern "C" void kernel_launch(void* const* d_in, const int* in_sizes, int n_in, void* d_out, int out_size, void* d_ws, size_t ws_size, hipStream_t stream) {
    static int grid = 0;
    if (grid == 0) {
        if (n_in != 22 || ws_size < W_END) { fprintf(stderr, "kernel_launch: unexpected inputs (n_in %d, ws %zu, need %zu)\n", n_in, ws_size, (size_t)W_END); grid = -1; return; }
        int dev = 0, cus = 0, per_cu = 0;
        (void)hipGetDevice(&dev); (void)hipDeviceGetAttribute(&cus, hipDeviceAttributeMultiprocessorCount, dev);
        if (hipFuncSetAttribute((const void*)fwd_megakernel, hipFuncAttributeMaxDynamicSharedMemorySize, LDS_BYTES) != hipSuccess) { fprintf(stderr, "hipFuncSetAttribute failed\n"); grid = -1; return; }
        if (hipOccupancyMaxActiveBlocksPerMultiprocessor(&per_cu, (const void*)fwd_megakernel, 512, LDS_BYTES) != hipSuccess || per_cu < 1) { fprintf(stderr, "occupancy query failed (%d)\n", per_cu); per_cu = 1; (void)hipGetLastError(); }
        grid = cus * per_cu;
        if (grid > 256) grid = 256;
    }
    if (grid < 0) return;
    Params p{};
    const float** pp = (const float**)&p;
    for (int i = 0; i < 22; ++i) pp[i] = (const float*)d_in[i];
    p.out = (float*)d_out; p.ws = (unsigned char*)d_ws;
#ifndef NLAUNCH
#define NLAUNCH 1
#endif
    for (int li = 0; li < NLAUNCH; ++li) {
        int lo = NLAUNCH == 1 ? 0 : li, hi = NLAUNCH == 1 ? (CUT >= 0 ? CUT + 1 : NPHASE) : li + 1;
        void* args[] = {&p, &lo, &hi};
        hipError_t e = hipLaunchCooperativeKernel((const void*)fwd_megakernel, dim3(grid), dim3(512), args, LDS_BYTES, stream);
        if (e != hipSuccess) { fprintf(stderr, "cooperative launch failed: %s (grid %d)\n", hipGetErrorString(e), grid); break; }
    }
    if (CUT >= 0) hipLaunchKernelGGL(dump_kernel, dim3(2048), dim3(256), 0, stream, p);
}
```

```cpp
#include <hip/hip_runtime.h>
#include <hip/hip_bf16.h>
#include <hip/hip_cooperative_groups.h>
#include <cstdio>
namespace cg = cooperative_groups;
namespace pg8 {
#define PG8_LAS __attribute__((address_space(3)))
typedef unsigned short bf16_t;
typedef short bf16x8 __attribute__((ext_vector_type(8)));
typedef float f32x4 __attribute__((ext_vector_type(4)));
typedef unsigned u32x4 __attribute__((ext_vector_type(4)));
constexpr int BM = 256, BK = 64, HALF = 128, HTB = HALF * BK * 2  , STAGE_BYTES = 8 * HTB, NXCD = 8, WGM = 8;

__host__ __device__ __forceinline__ int lds_byte(int r, int c) { const int st = (r >> 4) * 2 + (c >> 5), rr = r & 15, cc = c & 31, ob = rr * 64 + cc * 2; return st * 1024 + (ob ^ (((ob >> 9) & 1) << 5)); }
__host__ __device__ __forceinline__ void stage_rc(int b, int& R, int& C) { const int st = b / 1024, sb = b % 1024, swz = sb ^ (((sb >> 9) & 1) << 5); R = (st >> 1) * 16 + swz / 64; C = (st & 1) * 32 + (swz % 64) / 2; }
__host__ __device__ __forceinline__ int perm32(int rho) { const int n = rho >> 4, i = rho & 15; return 8 * (i >> 2) + 4 * n + (i & 3); }

struct Unit { int pm, pn; };
struct Gemm { const bf16_t* A; const bf16_t* Bt; int M, N, K; };

struct StaticOrder {
    int nM, nN, nwg, G, c;
    __host__ __device__ void init(int M, int N, int G_, int c_) { nM = M / BM; nN = N / BM; nwg = nM * nN; G = G_; c = c_; }
    __host__ __device__ bool next(int i, Unit& u) const {
        const long L = (long)i * G + c; if (L >= nwg) return false;
        int wgid = (int)L; { const int q = nwg / NXCD, r = nwg % NXCD, xcd = wgid % NXCD, off = wgid / NXCD; wgid = (xcd < r ? xcd * (q + 1) : r * (q + 1) + (xcd - r) * q) + off; }
        const int nig = WGM * nN, gid = wgid / nig, fm = gid * WGM, gsz = (nM - fm) < WGM ? (nM - fm) : WGM;
        u.pm = fm + ((wgid % nig) % gsz); u.pn = (wgid % nig) / gsz; return true;
    }
    __device__ __forceinline__ void a_ready(const Unit&) const {}
    __device__ __forceinline__ void done(const Unit&) const {}
};
__device__ __forceinline__ unsigned cvt_pk_bf16(float lo, float hi) { unsigned r; asm volatile("v_cvt_pk_bf16_f32 %0, %1, %2" : "=v"(r) : "v"(lo), "v"(hi)); return r; }
typedef float f32x2 __attribute__((ext_vector_type(2)));
__device__ __forceinline__ f32x2 gelu_pk(f32x2 v) {
    const f32x2 av = __builtin_elementwise_abs(v), d = av * 0.2316418882f + 1.0f;
    f32x2 t; t.x = __builtin_amdgcn_rcpf(d.x); t.y = __builtin_amdgcn_rcpf(d.y);
    f32x2 q = t * 0.5307027145f + (-0.7265760135f); q = q * t + 0.7107068705f; q = q * t + (-0.142248368f); q = q * t + 0.127414796f; q = q * t;
    const f32x2 s = (v * v) * (-0.72134752044f);
    f32x2 e; e.x = __builtin_amdgcn_exp2f(s.x); e.y = __builtin_amdgcn_exp2f(s.y);
    const f32x2 m = v * (q * e), r = v - m;
    f32x2 o; o.x = v.x < 0.f ? m.x : r.x; o.y = v.y < 0.f ? m.y : r.y; return o;
}
template <class Epi, class Sched, bool STAMP = false>
__device__ __forceinline__ void gemm_phase(PG8_LAS unsigned char* lds, const Gemm g, const Sched& S, const Epi& E, unsigned long long* stamps) {
    const int tid = threadIdx.x, wid = __builtin_amdgcn_readfirstlane(tid >> 6), lane = tid & 63, wr = wid >> 2, wc = wid & 3, fr = lane & 15, fq = lane >> 4;
    const int K = g.K, nt = K / BK;
    int ts_lo = 0, ts_hi = 0, nts = 0; const unsigned long long rt_entry = STAMP ? (unsigned long long)wall_clock64() : 0ull;
#define PG8_STAMP() do { if (STAMP && wid == 0 && nts < 64) { const unsigned long long _c = (unsigned long long)clock64(); \
        ts_lo = (lane == nts) ? (int)(unsigned)_c : ts_lo; ts_hi = (lane == nts) ? (int)(unsigned)(_c >> 32) : ts_hi; ++nts; } } while (0)
    PG8_STAMP();
    unsigned voffA[2], voffB[2];
#pragma unroll
    for (int i = 0; i < 2; ++i) { int R, C; stage_rc(tid * 16 + i * 8192, R, C); const int Rb = Epi::PERM ? ((R & ~31) + perm32(R & 31)) : R;
        voffA[i] = (unsigned)(R * K + C) * 2u; voffB[i] = (unsigned)(Rb * K + C) * 2u; }
    const size_t kstep = (size_t)(BK * 2);
    const size_t hstep = (size_t)HALF * K * 2;
    const size_t tstep = 2 * hstep;
    const unsigned ldsw = (unsigned)wid * 1024u;
    const int aoff = lds_byte(wr * 64 + fr, fq * 8), boff = lds_byte(wc * 32 + fr, fq * 8);
#define PG8_SA(b, h) (((b) * 2 + (h)) * HTB)
#define PG8_SB(b, h) ((4 + (b) * 2 + (h)) * HTB)
#define PG8_STAGE(bufoff, gbase, voff) do { _Pragma("unroll") for (int _i = 0; _i < 2; ++_i) \
        __builtin_amdgcn_global_load_lds((const unsigned*)((const char*)(gbase) + (voff)[_i]), (PG8_LAS unsigned*)(lds + (bufoff) + ldsw + _i * 8192), 16, 0, 0); } while (0)
#define PG8_LDA(dst, b, h) do { _Pragma("unroll") for (int m = 0; m < 4; ++m) _Pragma("unroll") for (int k = 0; k < 2; ++k) dst[m][k] = *(const PG8_LAS bf16x8*)(lds + PG8_SA(b, h) + aoff + m * 2048 + k * 1024); } while (0)
#define PG8_LDB(dst, b, h) do { _Pragma("unroll") for (int n = 0; n < 2; ++n) _Pragma("unroll") for (int k = 0; k < 2; ++k) dst[n][k] = *(const PG8_LAS bf16x8*)(lds + PG8_SB(b, h) + boff + n * 2048 + k * 1024); } while (0)
#define PG8_MMA(ai, bj, At, Bt) do { __builtin_amdgcn_s_setprio(1); _Pragma("unroll") for (int m = 0; m < 4; ++m) _Pragma("unroll") for (int n = 0; n < 2; ++n) _Pragma("unroll") for (int k = 0; k < 2; ++k) \
        acc[ai][bj][m][n] = __builtin_amdgcn_mfma_f32_16x16x32_bf16(Bt[n][k], At[m][k], acc[ai][bj][m][n], 0, 0, 0); __builtin_amdgcn_s_setprio(0); } while (0)
#define PG8_WAIT_V(n) asm volatile("s_waitcnt vmcnt(" #n ")" ::: "memory")
#define PG8_WAIT_L(n) asm volatile("s_waitcnt lgkmcnt(" #n ")" ::: "memory")
#define PG8_BAR __builtin_amdgcn_s_barrier()
#define PG8_SCHED __builtin_amdgcn_sched_barrier(0)
    Unit cur, nxt; int ui = 0;
    if (!S.next(0, cur)) return;
    f32x4 acc[2][2][4][2];
#pragma unroll
    for (int a = 0; a < 2; ++a)
#pragma unroll
        for (int b = 0; b < 2; ++b)
#pragma unroll
            for (int m = 0; m < 4; ++m)
#pragma unroll
                for (int n = 0; n < 2; ++n) acc[a][b][m][n] = (f32x4){0.f, 0.f, 0.f, 0.f};
    bf16x8 At[4][2], B0[2][2], B1[2][2];
    const char* cA = (const char*)g.A + (size_t)cur.pm * tstep; const char* cB = (const char*)g.Bt + (size_t)cur.pn * tstep;
    S.a_ready(cur);
    PG8_STAGE(PG8_SB(0, 0), cB, voffB); PG8_STAGE(PG8_SA(0, 0), cA, voffA); PG8_STAGE(PG8_SB(0, 1), cB + hstep, voffB); PG8_STAGE(PG8_SA(0, 1), cA + hstep, voffA);
    if (wr == 1) PG8_BAR;
    PG8_WAIT_V(4); PG8_BAR;
    PG8_STAGE(PG8_SB(1, 0), cB + kstep, voffB); PG8_STAGE(PG8_SA(1, 0), cA + kstep, voffA); PG8_STAGE(PG8_SB(1, 1), cB + hstep + kstep, voffB);
    PG8_WAIT_V(6); PG8_BAR;
    PG8_STAMP();
    for (;;) {
        const bool has_next = S.next(ui + 1, nxt);
        const char* nA = has_next ? (const char*)g.A + (size_t)nxt.pm * tstep : cA; const char* nB = has_next ? (const char*)g.Bt + (size_t)nxt.pn * tstep : cB;
        for (int t = 0; t < nt; t += 2) {
            const bool last = (t == nt - 2);
            const char* a1 = cA + (size_t)(t + 1) * kstep;
            const char* a2 = last ? nA : cA + (size_t)(t + 2) * kstep; const char* b2 = last ? nB : cB + (size_t)(t + 2) * kstep;
            const char* a3 = a2 + kstep; const char* b3 = b2 + kstep;
            if (last && has_next) S.a_ready(nxt);
            PG8_LDB(B0, 0, 0); PG8_SCHED; PG8_LDA(At, 0, 0); PG8_STAGE(PG8_SA(1, 1), a1 + hstep, voffA);
            PG8_WAIT_L(8); PG8_BAR; PG8_WAIT_L(0); PG8_MMA(0, 0, At, B0); PG8_BAR; PG8_SCHED;
            PG8_LDB(B1, 0, 1); PG8_STAGE(PG8_SB(0, 0), b2, voffB);
            PG8_BAR; PG8_WAIT_L(0); PG8_MMA(0, 1, At, B1); PG8_BAR;
            PG8_LDA(At, 0, 1); PG8_STAGE(PG8_SA(0, 0), a2, voffA);
            PG8_BAR; PG8_WAIT_L(0); PG8_MMA(1, 0, At, B0); PG8_BAR; PG8_SCHED;
            PG8_STAGE(PG8_SB(0, 1), b2 + hstep, voffB);
            PG8_WAIT_V(6); PG8_BAR; PG8_MMA(1, 1, At, B1); PG8_BAR;
            PG8_LDB(B0, 1, 0); PG8_SCHED; PG8_LDA(At, 1, 0); PG8_STAGE(PG8_SA(0, 1), a2 + hstep, voffA);
            PG8_WAIT_L(8); PG8_BAR; PG8_WAIT_L(0); PG8_MMA(0, 0, At, B0); PG8_BAR; PG8_SCHED;
            PG8_LDB(B1, 1, 1); PG8_STAGE(PG8_SB(1, 0), b3, voffB);
            PG8_BAR; PG8_WAIT_L(0); PG8_MMA(0, 1, At, B1); PG8_BAR;
            PG8_LDA(At, 1, 1); PG8_STAGE(PG8_SA(1, 0), a3, voffA);
            PG8_BAR; PG8_WAIT_L(0); PG8_MMA(1, 0, At, B0); PG8_BAR; PG8_SCHED;
            PG8_STAGE(PG8_SB(1, 1), b3 + hstep, voffB);
            PG8_WAIT_V(6); PG8_BAR; PG8_MMA(1, 1, At, B1); PG8_BAR;
        }
        PG8_STAMP();
        if constexpr (!Epi::AFTER_DRAIN) { E(acc, cur, wr, wc, fr, fq); S.done(cur); }
        PG8_STAMP();
        if (!has_next) break;
#pragma unroll
        for (int a = 0; a < 2; ++a)
#pragma unroll
            for (int b = 0; b < 2; ++b)
#pragma unroll
                for (int m = 0; m < 4; ++m)
#pragma unroll
                    for (int n = 0; n < 2; ++n) acc[a][b][m][n] = (f32x4){0.f, 0.f, 0.f, 0.f};
        cur = nxt; cA = nA; cB = nB; ++ui;
    }
    PG8_WAIT_V(0);
    if (wr == 0) PG8_BAR;
    PG8_BAR;
    if constexpr (Epi::AFTER_DRAIN) { E.fused(acc, cur, wr, wc, fr, fq, lds, wid, lane); S.done(cur); }
    PG8_STAMP();
    if (STAMP && wid == 0) { stamps[lane] = lane < nts ? (((unsigned long long)(unsigned)ts_hi << 32) | (unsigned)ts_lo) : 0ull;
        if (lane == 62) stamps[62] = rt_entry; if (lane == 63) stamps[63] = (unsigned long long)wall_clock64(); }
#undef PG8_STAMP
#undef PG8_SA
#undef PG8_SB
#undef PG8_STAGE
#undef PG8_LDA
#undef PG8_LDB
#undef PG8_MMA
#undef PG8_WAIT_V
#undef PG8_WAIT_L
#undef PG8_BAR
#undef PG8_SCHED
}
}
using pg8::bf16_t; using pg8::bf16x8; using pg8::f32x4; using pg8::u32x4;
typedef unsigned u32x2 __attribute__((ext_vector_type(2)));
#define DI __device__ __forceinline__
#define LAS __attribute__((address_space(3)))

constexpr int DM = 2048, NB = 4, SEQ = 2048, CTX = 256, LROWS = NB * SEQ, TROWS = LROWS + NB * CTX;
constexpr int DFF = 5504, NIN = 18464, NINP = 18688, NMOD = 6 * DM;
constexpr float EPSN = 1e-6f;
constexpr size_t MiB = 1ull << 20;
constexpr size_t W_INT = 0, W_ORF = 0, W_ORB = 32 * MiB;
constexpr size_t W_H = 73 * MiB, W_OGF = 73 * MiB, W_H2 = 73 * MiB;
constexpr size_t W_RPT = 109 * MiB, W_GPT = 117 * MiB, W_OT = 125 * MiB;
constexpr size_t W_MOD = 133 * MiB, W_CDF = W_MOD + 256 * 1024, W_CDB = W_CDF + 640 * 1024, W_COS = 135 * MiB, W_SIN = 136 * MiB;
constexpr size_t W_SSQ = 137 * MiB;
constexpr size_t W_RQ = 138 * MiB, W_RK = 170 * MiB, W_RV = 206 * MiB, W_GQ = 242 * MiB, W_GK = 258 * MiB, W_GV = 276 * MiB,
                 W_RG = 312 * MiB, W_GG = 344 * MiB, W_MR = 376 * MiB, W_MG = 408 * MiB, W_GAB = 440 * MiB;
constexpr size_t W_QF = 444 * MiB + 512 * 1024, W_QB = W_QF + 16 * MiB, W_KF = W_QB + 16 * MiB, W_KB = W_KF + 18 * MiB;
constexpr size_t W_UPT = 512 * MiB + 512 * 1024, W_DNT = W_UPT + 43 * MiB;
constexpr size_t W_R = W_QF, W_G = W_R + 32 * MiB, W_T = W_RQ, W_Z = W_RK;
constexpr size_t W_AV = 138 * MiB, W_U = 312 * MiB;
constexpr size_t W_PART = 548 * MiB + 512 * 1024;
constexpr size_t W_END = 577 * MiB;

struct Params {
    const float *x, *c, *ctx, *c_ctx, *w_ada, *b_ada, *norm1_g, *w_in, *ret_decay, *gate_up, *gate_bias, *ret_g, *gla_g,
                *w_rp, *w_gp, *w_o, *norm2_g, *w_up, *conv_w, *conv_b, *w_down, *final_g;
    float* out; unsigned char* ws;
};

DI float bf2f(unsigned short b) { return __uint_as_float(((unsigned)b) << 16); }
typedef __bf16 bf16x2_t __attribute__((ext_vector_type(2)));
typedef float f32x2_t __attribute__((ext_vector_type(2)));
DI unsigned pk2(float a, float b) { const f32x2_t v = {a, b}; return __builtin_bit_cast(unsigned, __builtin_convertvector(v, bf16x2_t)); }
DI unsigned short f2bf(float a) { return (unsigned short)(pk2(a, 0.f) & 0xffffu); }
DI float lo16(unsigned u) { return __uint_as_float(u << 16); }
DI float hi16(unsigned u) { return __uint_as_float(u & 0xffff0000u); }
DI float sigmoidf_(float x) { return __builtin_amdgcn_rcpf(1.0f + __expf(-x)); }
DI float siluf_(float x) { return x * sigmoidf_(x); }
DI float logsigmoidf_(float x) { return fminf(x, 0.f) - log1pf(expf(-fabsf(x))); }
DI float wave_sum(float v) { for (int o = 32; o >= 1; o >>= 1) v += __shfl_xor(v, o); return v; }

struct MapPlain { DI int src(int n) const { return n; } DI float scale(int) const { return 1.f; } };
struct MapIn {
    DI int src(int n) const { return n < 14336 ? n : (n < 18432 ? n + 32 : (n < 18464 ? n - 18432 + 14336 : -1)); }
    DI float scale(int s) const { return ((s >= 2048 && s < 4096) || (s >= 9216 && s < 10240)) ? 0.0625f : 1.f; }
};
template <int KT, class Map> DI void convert_T(const float* __restrict__ src, int K, int ldsrc, bf16_t* __restrict__ dst, int Nd, Map map, LAS unsigned char* lds, int first, int stride) {
    constexpr int P = KT + 2;
    LAS unsigned short* T = (LAS unsigned short*)lds;
    const int tid = threadIdx.x, nkt = K / KT, ntiles = (Nd / 64) * nkt;
    const int kr = tid >> 4, c4 = tid & 15;
    __syncthreads();
    f32x4 v[KT / 32]; int sc = -1;
#define CVT_LOAD(t_) do { const int n0_ = ((t_) / nkt) * 64, k0_ = ((t_) % nkt) * KT; sc = map.src(n0_ + 4 * c4); \
        _Pragma("unroll") for (int i = 0; i < KT / 32; ++i) { v[i] = (f32x4){0.f, 0.f, 0.f, 0.f}; if (sc >= 0) v[i] = *(const f32x4*)(src + (size_t)(k0_ + kr + 32 * i) * ldsrc + sc); } } while (0)
    if (first < ntiles) CVT_LOAD(first);
    for (int t = first; t < ntiles; t += stride) {
        const int n0 = (t / nkt) * 64, k0 = (t % nkt) * KT;
        const float s = sc >= 0 ? map.scale(sc) : 0.f;
#pragma unroll
        for (int i = 0; i < KT / 32; ++i)
#pragma unroll
            for (int j = 0; j < 4; ++j) T[(4 * c4 + j) * P + kr + 32 * i] = f2bf(v[i][j] * s);
        if (t + stride < ntiles) CVT_LOAD(t + stride);
        __syncthreads();
        const int n = tid >> 3, ks = tid & 7;
#pragma unroll
        for (int i = 0; i < KT / 64; ++i) {
            const LAS unsigned* rp = (const LAS unsigned*)(T + n * P + 8 * ks + 64 * i);
            u32x4 w; w.x = rp[0]; w.y = rp[1]; w.z = rp[2]; w.w = rp[3];
            *(u32x4*)(dst + (size_t)(n0 + n) * K + k0 + 8 * ks + 64 * i) = w;
        }
        __syncthreads();
    }
#undef CVT_LOAD
}
DI void ada_phase(const Params& p, LAS unsigned char* lds) {
    float* mod = (float*)(p.ws + W_MOD);
    LAS float* sl = (LAS float*)lds;
    LAS float* red = sl + 5 * DM;
    __syncthreads();
    for (int i = threadIdx.x; i < 5 * DM; i += 512) { const int v = i >> 11, k = i & (DM - 1); sl[i] = siluf_(v < 4 ? p.c[v * DM + k] : p.c_ctx[k]); }
    __syncthreads();
    const int tid = threadIdx.x, cg4 = tid % 12, rl = tid / 12;
    for (int cb = blockIdx.x; cb < NMOD / 48; cb += gridDim.x) {
        const int n = cb * 48 + 4 * cg4;
        f32x4 acc[5];
#pragma unroll
        for (int v = 0; v < 5; ++v) acc[v] = (f32x4){0.f, 0.f, 0.f, 0.f};
        if (rl < 42) {
            for (int k0 = rl; k0 < DM; k0 += 42 * 7) {
                f32x4 w[7];
#pragma unroll
                for (int i = 0; i < 7; ++i) { const int k = k0 + 42 * i; w[i] = (f32x4){0.f, 0.f, 0.f, 0.f}; if (k < DM) w[i] = *(const f32x4*)(p.w_ada + (size_t)k * NMOD + n); }
#pragma unroll
                for (int i = 0; i < 7; ++i) { const int k = k0 + 42 * i; if (k < DM) {
#pragma unroll
                    for (int v = 0; v < 5; ++v) acc[v] += w[i] * sl[v * DM + k]; } }
            }
#pragma unroll
            for (int v = 0; v < 5; ++v) *(LAS f32x4*)(red + (rl * 12 + cg4) * 20 + 4 * v) = acc[v];
        }
        __syncthreads();
        if (tid < 240) {
            const int g = tid / 20, e = tid % 20; float s = 0.f;
            for (int r2 = 0; r2 < 42; ++r2) s += red[(r2 * 12 + g) * 20 + e];
            mod[(e >> 2) * NMOD + cb * 48 + 4 * g + (e & 3)] = s;
        }
        __syncthreads();
    }
}
DI void rope_table(const Params& p) {
    float* tc = (float*)(p.ws + W_COS); float* ts = (float*)(p.ws + W_SIN);
    for (int i = blockIdx.x * 512 + threadIdx.x; i < SEQ * 128; i += gridDim.x * 512) {
        const int pos = i >> 7, d = i & 127, j = d & 63;
        const float inv = exp2f(-(float)j * (13.287712379549449f / 64.0f));
        const float a = (d < 64 ? (float)(pos >> 6) : (float)(pos & 63)) * inv;
        tc[i] = __cosf(a); ts[i] = __sinf(a);
    }
}
template <int MODE> DI void norm_phase(const Params& p, int nrows, const float* src_lat, const float* src_ctx, const float* gain, int sh_off, int sc_off, bf16_t* outb, float* outf) {
    const float* mod = (const float*)(p.ws + W_MOD);
    const int lane = threadIdx.x & 63, gw = blockIdx.x * 8 + (threadIdx.x >> 6), nw = gridDim.x * 8;
    for (int rowa = gw; rowa < nrows; rowa += 2 * nw) {
        int rows[2] = {rowa, rowa + nw}; const bool has2 = rows[1] < nrows; if (!has2) rows[1] = rowa;
        f32x4 t[2][8]; float ss[2] = {0.f, 0.f};
#pragma unroll
        for (int k = 0; k < 2; ++k) { const int row = rows[k]; const float* s = row < LROWS ? src_lat + (size_t)row * DM : src_ctx + (size_t)(row - LROWS) * DM;
#pragma unroll
            for (int i = 0; i < 8; ++i) t[k][i] = *(const f32x4*)(s + 4 * lane + 256 * i); }
#pragma unroll
        for (int k = 0; k < 2; ++k) {
#pragma unroll
            for (int i = 0; i < 8; ++i) ss[k] += t[k][i][0] * t[k][i][0] + t[k][i][1] * t[k][i][1] + t[k][i][2] * t[k][i][2] + t[k][i][3] * t[k][i][3];
            ss[k] = wave_sum(ss[k]); }
#pragma unroll
        for (int k = 0; k < 2; ++k) {
            if (k == 1 && !has2) break;
            const int row = rows[k], v = row < LROWS ? row / SEQ : 4;
            const float rs = rsqrtf(ss[k] * (1.0f / DM) + EPSN);
#pragma unroll
            for (int i = 0; i < 8; ++i) {
                if (i == 4) __builtin_amdgcn_sched_barrier(0);
                const int col = 4 * lane + 256 * i;
                const f32x4 g = *(const f32x4*)(gain + col);
                if (MODE == 0) {
                    const f32x4 sh = *(const f32x4*)(mod + v * NMOD + sh_off + col) + *(const f32x4*)(p.b_ada + sh_off + col);
                    const f32x4 sc = *(const f32x4*)(mod + v * NMOD + sc_off + col) + *(const f32x4*)(p.b_ada + sc_off + col);
                    t[k][i] = (t[k][i] * rs) * g * (sc + 1.0f) + sh;
                } else t[k][i] = (t[k][i] * rs) * g;
            }
#pragma unroll
            for (int i = 0; i < 8; ++i) {
                const int col = 4 * lane + 256 * i;
                if (MODE == 0) { u32x2 w; w.x = pk2(t[k][i][0], t[k][i][1]); w.y = pk2(t[k][i][2], t[k][i][3]); *(u32x2*)(outb + (size_t)row * DM + col) = w; }
                else *(f32x4*)(outf + (size_t)row * DM + col) = t[k][i];
            }
        }
    }
}
struct SchedIn {
    pg8::StaticOrder so; int G, c;
    DI void init(int G_, int c_) { so.init(LROWS, NINP, G_, c_); G = G_; c = c_; }
    DI bool next(int i, pg8::Unit& u) const {
        const int L = i * G + c;
        if (L < 32 * 73) return so.next(i, u);
        const int j = L - 32 * 73; if (j >= 4 * 29) return false;
        u.pm = 32 + (j & 3); const int q = j >> 2;
        u.pn = q < 8 ? 8 + q : (q < 16 ? 16 + (q - 8) : (q < 20 ? 36 + (q - 16) : (q < 28 ? 40 + (q - 20) : 72)));
        return true;
    }
    DI void a_ready(const pg8::Unit&) const {}
    DI void done(const pg8::Unit&) const {}
};
struct EpiIn {
    static constexpr bool PERM = true, AFTER_DRAIN = false;
    unsigned char* ws;
    DI void operator()(const f32x4 (&acc)[2][2][4][2], const pg8::Unit& u, int wr, int wc, int fr, int fq) const {
        const int pn = u.pn; size_t off; int ld, ct;
        if (pn < 8) { off = W_RQ; ld = 2048; ct = pn; } else if (pn < 16) { off = W_RK; ld = 2048; ct = pn - 8; } else if (pn < 24) { off = W_RV; ld = 2048; ct = pn - 16; }
        else if (pn < 32) { off = W_RG; ld = 2048; ct = pn - 24; } else if (pn < 36) { off = W_GQ; ld = 1024; ct = pn - 32; } else if (pn < 40) { off = W_GK; ld = 1024; ct = pn - 36; }
        else if (pn < 48) { off = W_GV; ld = 2048; ct = pn - 40; } else if (pn < 56) { off = W_GG; ld = 2048; ct = pn - 48; } else if (pn < 64) { off = W_MR; ld = 2048; ct = pn - 56; }
        else if (pn < 72) { off = W_MG; ld = 2048; ct = pn - 64; } else { off = W_GAB; ld = 256; ct = 0; }
        bf16_t* base = (bf16_t*)(ws + off);
        const int row0 = u.pm * 256 + wr * 64 + fr, col0 = ct * 256 + wc * 32 + 8 * fq;
        const bool rope = pn < 16 && u.pm < 32;
        const float* tc = (const float*)(ws + W_COS); const float* tsn = (const float*)(ws + W_SIN);
#pragma unroll
        for (int ai = 0; ai < 2; ++ai)
#pragma unroll
            for (int mp = 0; mp < 2; ++mp) {
                f32x4 cs[2][4];
#pragma unroll
                for (int mi = 0; mi < 2; ++mi) { const int row = row0 + ai * 128 + (2 * mp + mi) * 16, to = (row & (SEQ - 1)) * 128 + wc * 32 + 8 * fq;
                    if (rope) { cs[mi][0] = *(const f32x4*)(tc + to); cs[mi][1] = *(const f32x4*)(tc + to + 4); cs[mi][2] = *(const f32x4*)(tsn + to); cs[mi][3] = *(const f32x4*)(tsn + to + 4); }
                    else { cs[mi][0] = cs[mi][1] = (f32x4){1.f, 1.f, 1.f, 1.f}; cs[mi][2] = cs[mi][3] = (f32x4){0.f, 0.f, 0.f, 0.f}; } }
#pragma unroll
                for (int mi = 0; mi < 2; ++mi) { const int m = 2 * mp + mi, row = row0 + ai * 128 + m * 16; bf16_t* rowp = base + (size_t)row * ld + col0;
                    f32x4 a0 = acc[ai][0][m][0], a1 = acc[ai][0][m][1], b0 = acc[ai][1][m][0], b1 = acc[ai][1][m][1];
                    if (rope) { const f32x4 c0 = cs[mi][0], c1 = cs[mi][1], s0 = cs[mi][2], s1 = cs[mi][3];
                        const f32x4 na0 = a0 * c0 - b0 * s0, nb0 = b0 * c0 + a0 * s0, na1 = a1 * c1 - b1 * s1, nb1 = b1 * c1 + a1 * s1;
                        a0 = na0; b0 = nb0; a1 = na1; b1 = nb1; }
                    u32x4 w; w.x = pg8::cvt_pk_bf16(a0[0], a0[1]); w.y = pg8::cvt_pk_bf16(a0[2], a0[3]); w.z = pg8::cvt_pk_bf16(a1[0], a1[1]); w.w = pg8::cvt_pk_bf16(a1[2], a1[3]);
                    *(u32x4*)rowp = w;
                    w.x = pg8::cvt_pk_bf16(b0[0], b0[1]); w.y = pg8::cvt_pk_bf16(b0[2], b0[3]); w.z = pg8::cvt_pk_bf16(b1[0], b1[1]); w.w = pg8::cvt_pk_bf16(b1[2], b1[3]);
                    *(u32x4*)(rowp + 128) = w; }
            }
    }
};
template <int MODE> struct EpiB {
    static constexpr bool PERM = true, AFTER_DRAIN = false;
    bf16_t* O; int ld; const bf16_t* g1; const bf16_t* add;
    DI void operator()(const f32x4 (&acc)[2][2][4][2], const pg8::Unit& u, int wr, int wc, int fr, int fq) const {
        const int row0 = u.pm * 256 + wr * 64 + fr, col0 = u.pn * 256 + wc * 32 + 8 * fq;
#pragma unroll
        for (int ai = 0; ai < 2; ++ai)
#pragma unroll
            for (int m = 0; m < 4; ++m) { const size_t ro = (size_t)(row0 + ai * 128 + m * 16) * ld + col0;
#pragma unroll
                for (int bj = 0; bj < 2; ++bj) { f32x4 v0 = acc[ai][bj][m][0], v1 = acc[ai][bj][m][1];
                    if (MODE >= 1) { const u32x4 gg = *(const u32x4*)(g1 + ro + bj * 128);
                        v0[0] *= sigmoidf_(lo16(gg.x)); v0[1] *= sigmoidf_(hi16(gg.x)); v0[2] *= sigmoidf_(lo16(gg.y)); v0[3] *= sigmoidf_(hi16(gg.y));
                        v1[0] *= sigmoidf_(lo16(gg.z)); v1[1] *= sigmoidf_(hi16(gg.z)); v1[2] *= sigmoidf_(lo16(gg.w)); v1[3] *= sigmoidf_(hi16(gg.w)); }
                    if (MODE == 2) { const u32x4 aa = *(const u32x4*)(add + ro + bj * 128);
                        v0[0] += lo16(aa.x); v0[1] += hi16(aa.x); v0[2] += lo16(aa.y); v0[3] += hi16(aa.y);
                        v1[0] += lo16(aa.z); v1[1] += hi16(aa.z); v1[2] += lo16(aa.w); v1[3] += hi16(aa.w); }
                    u32x4 w; w.x = pg8::cvt_pk_bf16(v0[0], v0[1]); w.y = pg8::cvt_pk_bf16(v0[2], v0[3]); w.z = pg8::cvt_pk_bf16(v1[0], v1[1]); w.w = pg8::cvt_pk_bf16(v1[2], v1[3]);
                    *(u32x4*)(O + ro + bj * 128) = w; } }
    }
};
struct EpiRes {
    static constexpr bool PERM = false, AFTER_DRAIN = false;
    const float* base; float* out; const float* mod; const float* b_ada; int goff;
    DI void operator()(const f32x4 (&acc)[2][2][4][2], const pg8::Unit& u, int wr, int wc, int fr, int fq) const {
        const int row0 = u.pm * 256 + wr * 64 + fr, col0 = u.pn * 256 + wc * 32 + 4 * fq, b = u.pm >> 3;
        f32x4 gv[2][2];
#pragma unroll
        for (int bj = 0; bj < 2; ++bj)
#pragma unroll
            for (int n = 0; n < 2; ++n) gv[bj][n] = *(const f32x4*)(mod + b * NMOD + goff + col0 + bj * 128 + n * 16) + *(const f32x4*)(b_ada + goff + col0 + bj * 128 + n * 16);
#pragma unroll
        for (int ai = 0; ai < 2; ++ai)
#pragma unroll
            for (int mp = 0; mp < 2; ++mp) {
                f32x4 bs[2][2][2];
#pragma unroll
                for (int mi = 0; mi < 2; ++mi)
#pragma unroll
                    for (int bj = 0; bj < 2; ++bj)
#pragma unroll
                        for (int n = 0; n < 2; ++n) bs[mi][bj][n] = *(const f32x4*)(base + (size_t)(row0 + ai * 128 + (2 * mp + mi) * 16) * DM + col0 + bj * 128 + n * 16);
#pragma unroll
                for (int mi = 0; mi < 2; ++mi)
#pragma unroll
                    for (int bj = 0; bj < 2; ++bj)
#pragma unroll
                        for (int n = 0; n < 2; ++n) { const int m = 2 * mp + mi; *(f32x4*)(out + (size_t)(row0 + ai * 128 + m * 16) * DM + col0 + bj * 128 + n * 16) = bs[mi][bj][n] + gv[bj][n] * acc[ai][bj][m][n]; }
            }
    }
};

template <int MODE> struct EpiResNorm {
    static constexpr bool PERM = false, AFTER_DRAIN = true;
    const float* base; float* out; const float* mod; const float* b_ada; int goff; const float* fg; float* ssq; unsigned* cnt; bf16_t* hb; int sh_off, sc_off;
    DI void operator()(const f32x4 (&)[2][2][4][2], const pg8::Unit&, int, int, int, int) const {}
    DI void fused(f32x4 (&acc)[2][2][4][2], const pg8::Unit& u, int wr, int wc, int fr, int fq, LAS unsigned char* lds, int wid, int lane) const {
        LAS float* P = (LAS float*)lds;
        LAS float* R = P + 1024;
        const int row0 = u.pm * 256 + wr * 64 + fr, col0 = u.pn * 256 + wc * 32 + 4 * fq, b = u.pm >> 3;
        f32x4 gv[2][2];
#pragma unroll
        for (int bj = 0; bj < 2; ++bj)
#pragma unroll
            for (int n = 0; n < 2; ++n) gv[bj][n] = *(const f32x4*)(mod + b * NMOD + goff + col0 + bj * 128 + n * 16) + *(const f32x4*)(b_ada + goff + col0 + bj * 128 + n * 16);
#pragma unroll
        for (int ai = 0; ai < 2; ++ai)
#pragma unroll
            for (int mp = 0; mp < 2; ++mp) {
                f32x4 bs[2][2][2];
#pragma unroll
                for (int mi = 0; mi < 2; ++mi)
#pragma unroll
                    for (int bj = 0; bj < 2; ++bj)
#pragma unroll
                        for (int n = 0; n < 2; ++n) bs[mi][bj][n] = *(const f32x4*)(base + (size_t)(row0 + ai * 128 + (2 * mp + mi) * 16) * DM + col0 + bj * 128 + n * 16);
#pragma unroll
                for (int mi = 0; mi < 2; ++mi) { const int m = 2 * mp + mi; float s = 0.f;
#pragma unroll
                    for (int bj = 0; bj < 2; ++bj)
#pragma unroll
                        for (int n = 0; n < 2; ++n) { const f32x4 x = bs[mi][bj][n] + gv[bj][n] * acc[ai][bj][m][n]; acc[ai][bj][m][n] = x; s += (x[0] * x[0] + x[1] * x[1]) + (x[2] * x[2] + x[3] * x[3]); }
                    s += __shfl_xor(s, 16); s += __shfl_xor(s, 32);
                    if (fq == 0) P[(ai * 128 + wr * 64 + m * 16 + fr) * 4 + wc] = s; }
            }
        __syncthreads();
        const int t = threadIdx.x;
        if (t < 256) { const float s = (P[t * 4] + P[t * 4 + 1]) + (P[t * 4 + 2] + P[t * 4 + 3]);
            __hip_atomic_store(ssq + (size_t)(u.pm * 256 + t) * 8 + u.pn, s, __ATOMIC_RELAXED, __HIP_MEMORY_SCOPE_AGENT); }
        asm volatile("s_waitcnt vmcnt(0)" ::: "memory");
        if (t < 256 && lane == 0) __hip_atomic_fetch_add(cnt + 64 * u.pm, 1u, __ATOMIC_RELAXED, __HIP_MEMORY_SCOPE_AGENT);
        if (wid == 0) {
            unsigned sp = 0;
            while ((unsigned)__builtin_amdgcn_readfirstlane(__hip_atomic_load(cnt + 64 * u.pm, __ATOMIC_RELAXED, __HIP_MEMORY_SCOPE_AGENT)) < 32u) { __builtin_amdgcn_s_sleep(1); if (++sp > (1u << 22)) break; }
            __builtin_amdgcn_fence(__ATOMIC_ACQUIRE, "agent");
            asm volatile("s_waitcnt vmcnt(0)" ::: "memory");
        }
        __syncthreads();
        if (t < 256) { float s = 0.f;
#pragma unroll
            for (int k = 0; k < 8; ++k) s += __hip_atomic_load(ssq + (size_t)(u.pm * 256 + t) * 8 + k, __ATOMIC_RELAXED, __HIP_MEMORY_SCOPE_AGENT);
            R[t] = rsqrtf(s * (1.0f / DM) + EPSN); }
        __syncthreads();
        f32x4 gf[2][2], sh[2][2];
#pragma unroll
        for (int bj = 0; bj < 2; ++bj)
#pragma unroll
            for (int n = 0; n < 2; ++n) { const int c = col0 + bj * 128 + n * 16; gf[bj][n] = *(const f32x4*)(fg + c); sh[bj][n] = (f32x4){0.f, 0.f, 0.f, 0.f};
                if (MODE == 1) { gf[bj][n] *= (*(const f32x4*)(mod + b * NMOD + sc_off + c) + *(const f32x4*)(b_ada + sc_off + c)) + 1.0f; sh[bj][n] = *(const f32x4*)(mod + b * NMOD + sh_off + c) + *(const f32x4*)(b_ada + sh_off + c); } }
#pragma unroll
        for (int ai = 0; ai < 2; ++ai)
#pragma unroll
            for (int m = 0; m < 4; ++m) { const float rs = R[ai * 128 + wr * 64 + m * 16 + fr]; const size_t ro = (size_t)(row0 + ai * 128 + m * 16) * DM + col0;
#pragma unroll
                for (int bj = 0; bj < 2; ++bj)
#pragma unroll
                    for (int n = 0; n < 2; ++n) {
                        if (MODE == 0) *(f32x4*)(out + ro + bj * 128 + n * 16) = (acc[ai][bj][m][n] * rs) * gf[bj][n];
                        else { const f32x4 x = acc[ai][bj][m][n], y = (x * rs) * gf[bj][n] + sh[bj][n]; *(f32x4*)(out + ro + bj * 128 + n * 16) = x;
                               u32x2 w; w.x = pg8::cvt_pk_bf16(y[0], y[1]); w.y = pg8::cvt_pk_bf16(y[2], y[3]); *(u32x2*)(hb + ro + bj * 128 + n * 16) = w; } } }
    }
};
DI void map_tile(int L, int nM, int nN, int& pm, int& pn) {
    const int nwg = nM * nN; int wgid = L; { const int q = nwg / pg8::NXCD, r = nwg % pg8::NXCD, xcd = wgid % pg8::NXCD, off = wgid / pg8::NXCD; wgid = (xcd < r ? xcd * (q + 1) : r * (q + 1) + (xcd - r) * q) + off; }
    const int nig = pg8::WGM * nN, gid = wgid / nig, fm = gid * pg8::WGM, gsz = (nM - fm) < pg8::WGM ? (nM - fm) : pg8::WGM;
    pm = fm + ((wgid % nig) % gsz); pn = (wgid % nig) / gsz;
}
struct SchedRG {
    int G, c;
    DI void init(int G_, int c_) { G = G_; c = c_; }
    DI bool next(int i, pg8::Unit& u) const {
        const int L = i * G + c; if (L >= 512) return false;
        int pm, pn; map_tile(L & 255, 32, 8, pm, pn);
        u.pm = pm + (L >= 256 ? 32 : 0); u.pn = pn + (L >= 256 ? 8 : 0); return true;
    }
    DI void a_ready(const pg8::Unit&) const {}
    DI void done(const pg8::Unit&) const {}
};
struct EpiRG {
    static constexpr bool PERM = true, AFTER_DRAIN = false;
    unsigned char* ws;
    DI void operator()(const f32x4 (&acc)[2][2][4][2], const pg8::Unit& u, int wr, int wc, int fr, int fq) const {
        const bool second = u.pm >= 32; const int pm = u.pm - (second ? 32 : 0), pn = u.pn - (second ? 8 : 0);
        const bf16_t* g1 = (const bf16_t*)(ws + (second ? W_MG : W_MR)); const bf16_t* add = (const bf16_t*)(ws + W_T); bf16_t* O = (bf16_t*)(ws + (second ? W_Z : W_T));
        const int row0 = pm * 256 + wr * 64 + fr, col0 = pn * 256 + wc * 32 + 8 * fq;
#pragma unroll
        for (int ai = 0; ai < 2; ++ai)
#pragma unroll
            for (int mp = 0; mp < 2; ++mp) {
                u32x4 gg[2][2], aa[2][2];
#pragma unroll
                for (int mi = 0; mi < 2; ++mi)
#pragma unroll
                    for (int bj = 0; bj < 2; ++bj) { const size_t ro = (size_t)(row0 + ai * 128 + (2 * mp + mi) * 16) * DM + col0 + bj * 128;
                        gg[mi][bj] = *(const u32x4*)(g1 + ro); aa[mi][bj] = second ? *(const u32x4*)(add + ro) : (u32x4){0u, 0u, 0u, 0u}; }
#pragma unroll
                for (int mi = 0; mi < 2; ++mi)
#pragma unroll
                    for (int bj = 0; bj < 2; ++bj) { const int m = 2 * mp + mi; const size_t ro = (size_t)(row0 + ai * 128 + m * 16) * DM + col0 + bj * 128;
                        f32x4 v0 = acc[ai][bj][m][0], v1 = acc[ai][bj][m][1]; const u32x4 g = gg[mi][bj], a = aa[mi][bj];
                        v0[0] = v0[0] * sigmoidf_(lo16(g.x)) + lo16(a.x); v0[1] = v0[1] * sigmoidf_(hi16(g.x)) + hi16(a.x); v0[2] = v0[2] * sigmoidf_(lo16(g.y)) + lo16(a.y); v0[3] = v0[3] * sigmoidf_(hi16(g.y)) + hi16(a.y);
                        v1[0] = v1[0] * sigmoidf_(lo16(g.z)) + lo16(a.z); v1[1] = v1[1] * sigmoidf_(hi16(g.z)) + hi16(a.z); v1[2] = v1[2] * sigmoidf_(lo16(g.w)) + lo16(a.w); v1[3] = v1[3] * sigmoidf_(hi16(g.w)) + hi16(a.w);
                        u32x4 w; w.x = pg8::cvt_pk_bf16(v0[0], v0[1]); w.y = pg8::cvt_pk_bf16(v0[2], v0[3]); w.z = pg8::cvt_pk_bf16(v1[0], v1[1]); w.w = pg8::cvt_pk_bf16(v1[2], v1[3]);
                        *(u32x4*)(O + ro) = w; }
            }
    }
};
template <class Epi> DI void run_gemm(LAS unsigned char* lds, const bf16_t* A, const bf16_t* Bt, int M, int N, int K, const Epi& E) {
    pg8::Gemm g; g.A = A; g.Bt = Bt; g.M = M; g.N = N; g.K = K;
    pg8::StaticOrder so; so.init(M, N, gridDim.x, blockIdx.x);
    pg8::gemm_phase<Epi, pg8::StaticOrder, false>(lds, g, so, E, nullptr);
}
constexpr int TP = 264;
DI void tile_ld(const bf16_t* __restrict__ src, int ld, LAS bf16_t* T) {
#pragma unroll
    for (int k = 0; k < 4; ++k) { const int i = threadIdx.x + 512 * k, row = i >> 5, pc = i & 31; *(LAS u32x4*)(T + row * TP + pc * 8) = *(const u32x4*)(src + (size_t)row * ld + pc * 8); }
}
DI void tile_st(bf16_t* __restrict__ dst, int ld, const LAS bf16_t* T) {
#pragma unroll
    for (int k = 0; k < 4; ++k) { const int i = threadIdx.x + 512 * k, row = i >> 5, pc = i & 31; *(u32x4*)(dst + (size_t)row * ld + pc * 8) = *(const LAS u32x4*)(T + row * TP + pc * 8); }
}
DI void rope_inplace(const Params& p, bf16_t* rq) {
    const float* tc = (const float*)(p.ws + W_COS); const float* tsn = (const float*)(p.ws + W_SIN);
    for (int i = blockIdx.x * 512 + threadIdx.x; i < LROWS * 128; i += gridDim.x * 512) {
        const int g = i & 15, h = (i >> 4) & 7, row = i >> 7, pos = row & (SEQ - 1);
        bf16_t* a = rq + (size_t)row * 2048 + h * 256 + g * 8;
        const u32x4 v1 = *(const u32x4*)a, v2 = *(const u32x4*)(a + 128);
        const f32x4 c0 = *(const f32x4*)(tc + pos * 128 + g * 8), c1 = *(const f32x4*)(tc + pos * 128 + g * 8 + 4), s0 = *(const f32x4*)(tsn + pos * 128 + g * 8), s1 = *(const f32x4*)(tsn + pos * 128 + g * 8 + 4);
        const float x1[8] = {lo16(v1.x), hi16(v1.x), lo16(v1.y), hi16(v1.y), lo16(v1.z), hi16(v1.z), lo16(v1.w), hi16(v1.w)};
        const float x2[8] = {lo16(v2.x), hi16(v2.x), lo16(v2.y), hi16(v2.y), lo16(v2.z), hi16(v2.z), lo16(v2.w), hi16(v2.w)};
        float y1[8], y2[8];
#pragma unroll
        for (int e = 0; e < 8; ++e) { const float cs = e < 4 ? c0[e] : c1[e - 4], sn = e < 4 ? s0[e] : s1[e - 4]; y1[e] = x1[e] * cs - x2[e] * sn; y2[e] = x2[e] * cs + x1[e] * sn; }
        u32x4 w1, w2; w1.x = pk2(y1[0], y1[1]); w1.y = pk2(y1[2], y1[3]); w1.z = pk2(y1[4], y1[5]); w1.w = pk2(y1[6], y1[7]);
        w2.x = pk2(y2[0], y2[1]); w2.y = pk2(y2[2], y2[3]); w2.z = pk2(y2[4], y2[5]); w2.w = pk2(y2[6], y2[7]);
        *(u32x4*)a = w1; *(u32x4*)(a + 128) = w2;
    }
}
template <int DIR> DI void prep_gla_dir(const Params& p, int ch, int h, int cch, int half, bool lat, LAS const float* ga, LAS bf16_t* Tq, LAS bf16_t* Tk, LAS float* tot) {
    const int col = h * 256 + cch;
    float* cd = (float*)(p.ws + (DIR ? W_CDB : W_CDF));
    float up[16];
#pragma unroll
    for (int r = 0; r < 16; ++r) up[r] = p.gate_up[((size_t)DIR * 16 + r) * 1024 + col];
    const float bias = p.gate_bias[DIR * 1024 + col];
    float bl[32]; float b = 0.f;
#pragma unroll
    for (int e = 0; e < 32; ++e) {
        const int ss = 32 * half + e, t = DIR ? 63 - ss : ss;
        float z = bias;
#pragma unroll
        for (int r = 0; r < 16; ++r) z += ga[t * 16 + r] * up[r];
        b += (fminf(z, 0.f) - __logf(1.0f + __expf(-fabsf(z)))) * 0.0625f;
        bl[e] = b;
    }
    if (half == 0) tot[cch] = b;
    __syncthreads();
    const float off = half ? tot[cch] : 0.f;
#pragma unroll
    for (int e = 0; e < 32; ++e) {
        const int ss = 32 * half + e, t = DIR ? 63 - ss : ss;
        const float bb = bl[e] + off, eb = __expf(bb), ebi = __expf(-bb);
        if (lat) Tq[t * TP + cch] = f2bf(bf2f(Tq[t * TP + cch]) * eb);
        Tk[t * TP + cch] = f2bf(bf2f(Tk[t * TP + cch]) * ebi);
    }
    if (half) cd[ch * 1024 + col] = __expf(b + off);
}
DI void prep_gla(const Params& p, LAS unsigned char* lds) {
    LAS bf16_t* Tq = (LAS bf16_t*)lds; LAS bf16_t* Tk = Tq + 64 * TP; LAS float* ga = (LAS float*)(Tk + 64 * TP); LAS float* tot = ga + 64 * 16;
    const bf16_t* gab = (const bf16_t*)(p.ws + W_GAB);
    for (int it = blockIdx.x; it < 144 * 8; it += gridDim.x) {
        const int ch = it >> 3, h = (it >> 1) & 3, dir = it & 1, tid = threadIdx.x;
        const bool lat = ch < 128;
        __syncthreads();
        if (lat) tile_ld((const bf16_t*)(p.ws + W_GQ) + (size_t)ch * 64 * 1024 + h * 256, 1024, Tq);
        tile_ld((const bf16_t*)(p.ws + W_GK) + (size_t)ch * 64 * 1024 + h * 256, 1024, Tk);
#pragma unroll
        for (int i = 0; i < 2; ++i) { const int e = tid + 512 * i, t = e >> 4, r = e & 15; ga[e] = bf2f(gab[((size_t)ch * 64 + t) * 256 + dir * 16 + r]); }
        __syncthreads();
        if (dir == 0) prep_gla_dir<0>(p, ch, h, tid & 255, tid >> 8, lat, ga, Tq, Tk, tot); else prep_gla_dir<1>(p, ch, h, tid & 255, tid >> 8, lat, ga, Tq, Tk, tot);
        __syncthreads();
        if (lat) tile_st((bf16_t*)(p.ws + (dir ? W_QB : W_QF)) + (size_t)ch * 64 * 1024 + h * 256, 1024, Tq);
        tile_st((bf16_t*)(p.ws + (dir ? W_KB : W_KF)) + (size_t)ch * 64 * 1024 + h * 256, 1024, Tk);
    }
}
#define MFMA16(a, b, c) __builtin_amdgcn_mfma_f32_16x16x32_bf16((a), (b), (c), 0, 0, 0)
constexpr int QP = 264, KTP = 72;
#define GAS __attribute__((address_space(1)))
template <class T> DI GAS T* uni(T* p) { const unsigned long long v = (unsigned long long)p; const unsigned lo = __builtin_amdgcn_readfirstlane((unsigned)v), hi = __builtin_amdgcn_readfirstlane((unsigned)(v >> 32)); return (GAS T*)(((unsigned long long)hi << 32) | lo); }
typedef short s16x4 __attribute__((ext_vector_type(4)));
constexpr int VP = 136;
DI bf16x8 tr_frag(LAS const bf16_t* T, int pitch_b, int k0, int c0, int r, int g) {
    LAS const char* a = (LAS const char*)T + (k0 + 8 * g + (r >> 2)) * pitch_b + c0 * 2 + 8 * (r & 3);
    const s16x4 lo = __builtin_amdgcn_ds_read_tr16_b64_v4i16((LAS s16x4*)a), hi = __builtin_amdgcn_ds_read_tr16_b64_v4i16((LAS s16x4*)(a + 4 * pitch_b));
    return (bf16x8){lo[0], lo[1], lo[2], lo[3], hi[0], hi[1], hi[2], hi[3]};
}
DI void scan_phase(const Params& p, LAS unsigned char* lds) {
    LAS bf16_t* Qs = (LAS bf16_t*)lds; LAS bf16_t* Ks2 = Qs + 64 * QP; LAS bf16_t* Vs = Ks2 + 2 * 64 * QP; LAS bf16_t* Sc = Vs + 64 * VP; LAS float* Cd2 = (LAS float*)(Sc + 64 * KTP);
    const int tid = threadIdx.x, wid = __builtin_amdgcn_readfirstlane(tid >> 6), lane = tid & 63, r = lane & 15, q = lane >> 4, nh = wid >> 2;
    for (int u0 = blockIdx.x; u0 < 256; u0 += gridDim.x) {
        const int u = (u0 & 7) * 32 + (u0 >> 3);
        const bool ret = u < 128; int b, h, dir, part;
        if (ret) { b = u >> 5; h = (u >> 2) & 7; dir = (u >> 1) & 1; part = u & 1; } else { const int v = u - 128; b = v >> 5; h = (v >> 3) & 3; dir = (v >> 2) & 1; part = v & 3; }
        const bf16_t* qb = (const bf16_t*)(p.ws + (ret ? W_RQ : (dir ? W_QB : W_QF))) + h * 256;
        const bf16_t* kb = (const bf16_t*)(p.ws + (ret ? W_RK : (dir ? W_KB : W_KF))) + h * 256;
        const int ldqk = ret ? 2048 : 1024, vcol = ret ? h * 256 + part * 128 : h * 512 + part * 128;
        const bf16_t* vb = (const bf16_t*)(p.ws + (ret ? W_RV : W_GV)) + vcol;
        bf16_t* ob = (ret ? (bf16_t*)(p.ws + (dir ? W_ORB : W_ORF)) : (dir ? (bf16_t*)p.out : (bf16_t*)(p.ws + W_OGF))) + vcol + 16 * wid;
        const unsigned lo_o = (unsigned)(r * 2048 + 4 * q) * 2u;
        const float* cdb = (const float*)(p.ws + (dir ? W_CDB : W_CDF)) + h * 256;
        float c2 = 0.f, g64 = 1.f;
        if (ret) { c2 = logsigmoidf_(p.ret_decay[dir * 8 + h]) * 1.4426950408889634f; g64 = __builtin_amdgcn_exp2f(64.f * c2); }
        float Lv[2], Lo, Uv[8], Uo[4];
#pragma unroll
        for (int s = 0; s < 2; ++s) Lv[s] = __builtin_amdgcn_exp2f((dir ? -(float)(64 - 32 * s - 8 * q) : -(float)(32 * s + 8 * q + 1)) * c2);
        Lo = __builtin_amdgcn_exp2f((dir ? (float)(64 - r) : (float)(r + 1)) * c2);
#pragma unroll
        for (int j = 0; j < 8; ++j) Uv[j] = __uint_as_float(__builtin_amdgcn_readfirstlane(__float_as_uint(__builtin_amdgcn_exp2f((dir ? (float)j : -(float)j) * c2))));
#pragma unroll
        for (int nt = 0; nt < 4; ++nt) Uo[nt] = __uint_as_float(__builtin_amdgcn_readfirstlane(__float_as_uint(__builtin_amdgcn_exp2f((dir ? -(float)(16 * nt) : (float)(16 * nt)) * c2))));
        float UoW[4];
#pragma unroll
        for (int nt = 0; nt < 4; ++nt) UoW[nt] = nh ? Uo[(nt + 2) & 3] : Uo[nt];
        f32x4 S[16];
#pragma unroll
        for (int i = 0; i < 16; ++i) S[i] = (f32x4){0.f, 0.f, 0.f, 0.f};
        u32x4 pK[4], pQ[4], pV[2]; float pCd = 1.f;
        const int rr = tid >> 3, c0 = (tid & 7) * 8;
        const unsigned lo_qk = (unsigned)(rr * ldqk + c0) * 2u, lo_vv = (unsigned)(rr * 2048 + (tid & 7) * 16) * 2u;
#define SCAN_ROW0(st_) (((st_) >= 4) ? b * SEQ + 64 * (dir ? 35 - (st_) : (st_) - 4) : LROWS + b * CTX + 64 * (dir ? 3 - (st_) : (st_)))
#define SCAN_LOAD(st_) do { const int row0n = SCAN_ROW0(st_), cidn = row0n >> 6; \
            GAS const char* kr0 = uni((const char*)(kb + (size_t)row0n * ldqk)); GAS const char* qr0 = uni((const char*)(qb + (size_t)row0n * ldqk)); GAS const char* vr0 = uni((const char*)(vb + (size_t)row0n * 2048)); \
            _Pragma("unroll") for (int i = 0; i < 4; ++i) pK[i] = *(GAS const u32x4*)(kr0 + i * 128 + lo_qk); \
            if ((st_) >= 4) { _Pragma("unroll") for (int i = 0; i < 4; ++i) pQ[i] = *(GAS const u32x4*)(qr0 + i * 128 + lo_qk); } \
            pV[0] = *(GAS const u32x4*)(vr0 + lo_vv); pV[1] = *(GAS const u32x4*)(vr0 + 16 + lo_vv); \
            if (!ret && tid < 256) pCd = cdb[(size_t)cidn * 1024 + tid]; } while (0)
#define SCAN_PUT(st_) do { LAS bf16_t* Kn = Ks2 + ((st_) & 1) * 64 * QP; LAS float* Cn = Cd2 + ((st_) & 1) * 256; \
            _Pragma("unroll") for (int i = 0; i < 4; ++i) *(LAS u32x4*)(Kn + rr * QP + c0 + 64 * i) = pK[i]; \
            if ((st_) >= 4) { _Pragma("unroll") for (int i = 0; i < 4; ++i) *(LAS u32x4*)(Qs + rr * QP + c0 + 64 * i) = pQ[i]; } \
            *(LAS u32x4*)(Vs + rr * VP + (tid & 7) * 16) = pV[0]; *(LAS u32x4*)(Vs + rr * VP + (tid & 7) * 16 + 8) = pV[1]; \
            if (tid < 256) Cn[tid] = ret ? g64 : pCd; } while (0)
        SCAN_LOAD(0);
        __syncthreads();
        SCAN_PUT(0);
        for (int st = 0; st < 36; ++st) {
            const bool lat = st >= 4;
            const int row0 = SCAN_ROW0(st);
            LAS bf16_t* Ks = Ks2 + (st & 1) * 64 * QP; LAS float* Cd = Cd2 + (st & 1) * 256;
            __syncthreads();
            if (st + 1 < 36) SCAN_LOAD(st + 1);
            bf16x8 vf[2];
#pragma unroll
            for (int s = 0; s < 2; ++s) vf[s] = tr_frag(Vs, VP * 2, 32 * s, 16 * wid, r, q);
            if (ret) {
#pragma unroll
                for (int s = 0; s < 2; ++s)
#pragma unroll
                    for (int j = 0; j < 8; ++j) vf[s][j] = (short)f2bf(bf2f((unsigned short)vf[s][j]) * (Lv[s] * Uv[j]));
            }
            f32x4 o[4];
#pragma unroll
            for (int nt = 0; nt < 4; ++nt) o[nt] = (f32x4){0.f, 0.f, 0.f, 0.f};
            if (lat) {
                const int mt = wid & 3;
                f32x4 sc0 = (f32x4){0.f, 0.f, 0.f, 0.f}, sc1 = sc0;
#pragma unroll
                for (int ks = 0; ks < 8; ++ks) {
                    bf16x8 qf[4];
#pragma unroll
                    for (int nt = 0; nt < 4; ++nt) {
                        const int ntv = (nt + 2 * nh) & 3;
                        const u32x2 lo = *(const LAS u32x2*)(Qs + (16 * ntv + r) * QP + 32 * ks + 4 * q), hi = *(const LAS u32x2*)(Qs + (16 * ntv + r) * QP + 32 * ks + 16 + 4 * q);
                        u32x4 aa; aa.x = lo.x; aa.y = lo.y; aa.z = hi.x; aa.w = hi.y; qf[nt] = __builtin_bit_cast(bf16x8, aa);
                    }
                    bf16x8 kf;
                    { const u32x2 lo = *(const LAS u32x2*)(Ks + (16 * mt + r) * QP + 32 * ks + 4 * q), hi = *(const LAS u32x2*)(Ks + (16 * mt + r) * QP + 32 * ks + 16 + 4 * q);
                      u32x4 aa; aa.x = lo.x; aa.y = lo.y; aa.z = hi.x; aa.w = hi.y; kf = __builtin_bit_cast(bf16x8, aa); }
                    sc0 = MFMA16(kf, qf[0], sc0); sc1 = MFMA16(kf, qf[1], sc1);
                    u32x4 sw; sw.x = pk2(S[2 * ks][0], S[2 * ks][1]); sw.y = pk2(S[2 * ks][2], S[2 * ks][3]); sw.z = pk2(S[2 * ks + 1][0], S[2 * ks + 1][1]); sw.w = pk2(S[2 * ks + 1][2], S[2 * ks + 1][3]);
                    const bf16x8 sb = __builtin_bit_cast(bf16x8, sw);
#pragma unroll
                    for (int nt = 0; nt < 4; ++nt) o[nt] = MFMA16(sb, qf[nt], o[nt]);
                }
                {
                    const int m0 = 16 * mt + 4 * q, n0 = 32 * nh + r, n1 = n0 + 16;
#pragma unroll
                    for (int j = 0; j < 4; ++j) { const int m = m0 + j, d0 = dir ? m - n0 : n0 - m, d1 = dir ? m - n1 : n1 - m;
                        sc0[j] = d0 >= 0 ? sc0[j] : 0.f; sc1[j] = d1 >= 0 ? sc1[j] : 0.f; }
                    u32x2 w0, w1; w0.x = pk2(sc0[0], sc0[1]); w0.y = pk2(sc0[2], sc0[3]); w1.x = pk2(sc1[0], sc1[1]); w1.y = pk2(sc1[2], sc1[3]);
                    *(LAS u32x2*)(Sc + n0 * KTP + m0) = w0; *(LAS u32x2*)(Sc + n1 * KTP + m0) = w1;
                }
            }
            __syncthreads();
            if (st + 1 < 36) SCAN_PUT(st + 1);
            if (lat) {
#pragma unroll
                for (int s = 0; s < 2; ++s)
#pragma unroll
                    for (int nt = 0; nt < 4; ++nt) { const int ntv = (nt + 2 * nh) & 3; const bf16x8 a = *(const LAS bf16x8*)(Sc + (16 * ntv + r) * KTP + 32 * s + 8 * q); o[nt] = MFMA16(vf[s], a, o[nt]); }
#pragma unroll
                for (int nt = 0; nt < 4; ++nt) { const int ntv = (nt + 2 * nh) & 3; const float sc = Lo * UoW[nt];
                    u32x2 w; w.x = pk2(o[nt][0] * sc, o[nt][1] * sc); w.y = pk2(o[nt][2] * sc, o[nt][3] * sc);
                    *(GAS u32x2*)(uni((char*)(ob + (size_t)(row0 + 16 * ntv) * 2048)) + lo_o) = w; }
            }
#pragma unroll
            for (int cg = 0; cg < 4; ++cg) {
                bf16x8 af[4][2]; f32x4 cdv[4];
#pragma unroll
                for (int c4 = 0; c4 < 4; ++c4) {
#pragma unroll
                    for (int s = 0; s < 2; ++s) af[c4][s] = tr_frag(Ks, QP * 2, 32 * s, 16 * (4 * cg + c4), r, q);
                    cdv[c4] = *(const LAS f32x4*)(Cd + 16 * (4 * cg + c4) + 4 * q);
                }
                __builtin_amdgcn_sched_barrier(0);
#pragma unroll
                for (int c4 = 0; c4 < 4; ++c4) {
                    const int ct = 4 * cg + c4;
#pragma unroll
                    for (int s = 0; s < 2; ++s) S[ct] = MFMA16(af[c4][s], vf[s], S[ct]);
                }
#pragma unroll
                for (int c4 = 0; c4 < 4; ++c4) S[4 * cg + c4] *= cdv[c4];
            }
        }
    }
}
DI void readout_phase(const Params& p) {
    const bf16_t* orf = (const bf16_t*)(p.ws + W_ORF); const bf16_t* orb = (const bf16_t*)(p.ws + W_ORB); const bf16_t* ogf = (const bf16_t*)(p.ws + W_OGF); const bf16_t* ogb = (const bf16_t*)p.out;
    const bf16_t* rg = (const bf16_t*)(p.ws + W_RG); const bf16_t* gg = (const bf16_t*)(p.ws + W_GG); bf16_t* R = (bf16_t*)(p.ws + W_R); bf16_t* G = (bf16_t*)(p.ws + W_G);
    const int lane = threadIdx.x & 63, gw = blockIdx.x * 8 + (threadIdx.x >> 6), nw = gridDim.x * 8;
    for (int tok = gw; tok < LROWS; tok += nw) {
        {
            u32x2 a[8], bq[8], gt[8];
#pragma unroll
            for (int j = 0; j < 8; ++j) { const size_t off = (size_t)tok * 2048 + j * 256 + 4 * lane; a[j] = *(const u32x2*)(orf + off); bq[j] = *(const u32x2*)(orb + off); gt[j] = *(const u32x2*)(rg + off); }
            f32x4 gnr[8];
#pragma unroll
            for (int j = 0; j < 8; ++j) gnr[j] = *(const f32x4*)(p.ret_g + j * 256 + 4 * lane);
#pragma unroll
            for (int j = 0; j < 8; ++j) {
                float o[4] = {lo16(a[j].x) + lo16(bq[j].x), hi16(a[j].x) + hi16(bq[j].x), lo16(a[j].y) + lo16(bq[j].y), hi16(a[j].y) + hi16(bq[j].y)};
                const float mu = wave_sum(o[0] + o[1] + o[2] + o[3]) * (1.0f / 256.0f);
                float vs = 0.f;
#pragma unroll
                for (int e = 0; e < 4; ++e) { o[e] -= mu; vs += o[e] * o[e]; }
                const float rs = rsqrtf(wave_sum(vs) * (1.0f / 256.0f) + EPSN);
                const f32x4 gn = gnr[j];
                const float g4[4] = {lo16(gt[j].x), hi16(gt[j].x), lo16(gt[j].y), hi16(gt[j].y)};
                float y[4];
#pragma unroll
                for (int e = 0; e < 4; ++e) y[e] = o[e] * rs * gn[e] * siluf_(g4[e]);
                u32x2 w; w.x = pk2(y[0], y[1]); w.y = pk2(y[2], y[3]);
                *(u32x2*)(R + (size_t)tok * 2048 + j * 256 + 4 * lane) = w;
            }
        }
        {
            u32x4 a[4], bq[4], gt[4];
#pragma unroll
            for (int hh = 0; hh < 4; ++hh) { const size_t off = (size_t)tok * 2048 + hh * 512 + 8 * lane; a[hh] = *(const u32x4*)(ogf + off); bq[hh] = *(const u32x4*)(ogb + off); gt[hh] = *(const u32x4*)(gg + off); }
            f32x4 gng[4][2];
#pragma unroll
            for (int hh = 0; hh < 4; ++hh) { gng[hh][0] = *(const f32x4*)(p.gla_g + hh * 512 + 8 * lane); gng[hh][1] = *(const f32x4*)(p.gla_g + hh * 512 + 8 * lane + 4); }
#pragma unroll
            for (int hh = 0; hh < 4; ++hh) {
                float o[8] = {lo16(a[hh].x) + lo16(bq[hh].x), hi16(a[hh].x) + hi16(bq[hh].x), lo16(a[hh].y) + lo16(bq[hh].y), hi16(a[hh].y) + hi16(bq[hh].y), lo16(a[hh].z) + lo16(bq[hh].z), hi16(a[hh].z) + hi16(bq[hh].z), lo16(a[hh].w) + lo16(bq[hh].w), hi16(a[hh].w) + hi16(bq[hh].w)};
                float vs = 0.f;
#pragma unroll
                for (int e = 0; e < 8; ++e) vs += o[e] * o[e];
                const float rs = rsqrtf(wave_sum(vs) * (1.0f / 512.0f) + EPSN);
                const f32x4 gn0 = gng[hh][0], gn1 = gng[hh][1];
                const float g8[8] = {lo16(gt[hh].x), hi16(gt[hh].x), lo16(gt[hh].y), hi16(gt[hh].y), lo16(gt[hh].z), hi16(gt[hh].z), lo16(gt[hh].w), hi16(gt[hh].w)};
                float y[8];
#pragma unroll
                for (int e = 0; e < 8; ++e) y[e] = o[e] * rs * (e < 4 ? gn0[e] : gn1[e - 4]) * siluf_(g8[e]);
                u32x4 w; w.x = pk2(y[0], y[1]); w.y = pk2(y[2], y[3]); w.z = pk2(y[4], y[5]); w.w = pk2(y[6], y[7]);
                *(u32x4*)(G + (size_t)tok * 2048 + hh * 512 + 8 * lane) = w;
            }
        }
    }
}
DI float gelu_tanh(float x) { const float y = 0.7978845608028654f * (x + 0.044715f * x * x * x); return x * __builtin_amdgcn_rcpf(1.0f + __expf(-2.0f * y)); }
DI float dot2bf(unsigned a, unsigned b, float c) { return __builtin_amdgcn_fdot2_f32_bf16(__builtin_bit_cast(bf16x2_t, a), __builtin_bit_cast(bf16x2_t, b), c, false); }
DI void conv_phase(const Params& p) {
    const bf16_t* av = (const bf16_t*)(p.ws + W_AV); bf16_t* U = (bf16_t*)(p.ws + W_U);
    const int per_wg = (NB * 32 * 688 + (int)gridDim.x - 1) / (int)gridDim.x;
    for (int i = blockIdx.x * per_wg + threadIdx.x; i < NB * 32 * 688 && i < (int)(blockIdx.x + 1) * per_wg; i += 512) {
        const int f8 = (i % 688) * 8, br = i / 688, rr = br & 31, b = br >> 5;
        unsigned wlo[3][4], whi[3][4]; float ws[3][8], bias[8];
#pragma unroll
        for (int dc = 0; dc < 3; ++dc) {
            const f32x4 a0 = *(const f32x4*)(p.conv_w + (0 * 3 + dc) * DFF + f8), a1 = *(const f32x4*)(p.conv_w + (0 * 3 + dc) * DFF + f8 + 4);
            const f32x4 b0 = *(const f32x4*)(p.conv_w + (1 * 3 + dc) * DFF + f8), b1 = *(const f32x4*)(p.conv_w + (1 * 3 + dc) * DFF + f8 + 4);
            const f32x4 c0 = *(const f32x4*)(p.conv_w + (2 * 3 + dc) * DFF + f8), c1 = *(const f32x4*)(p.conv_w + (2 * 3 + dc) * DFF + f8 + 4);
            wlo[dc][0] = pk2(a0[0], b0[0]); whi[dc][0] = pk2(a0[1], b0[1]); wlo[dc][1] = pk2(a0[2], b0[2]); whi[dc][1] = pk2(a0[3], b0[3]);
            wlo[dc][2] = pk2(a1[0], b1[0]); whi[dc][2] = pk2(a1[1], b1[1]); wlo[dc][3] = pk2(a1[2], b1[2]); whi[dc][3] = pk2(a1[3], b1[3]);
#pragma unroll
            for (int e = 0; e < 4; ++e) { ws[dc][e] = c0[e]; ws[dc][4 + e] = c1[e]; }
        }
        { const f32x4 c0 = *(const f32x4*)(p.conv_b + f8), c1 = *(const f32x4*)(p.conv_b + f8 + 4);
#pragma unroll
          for (int e = 0; e < 4; ++e) { bias[e] = c0[e]; bias[4 + e] = c1[e]; } }
        const size_t tok0 = (size_t)b * 2048 + rr * 64;
        const bool okm = rr > 0, okp = rr < 31;
        const bf16_t* r0 = av + tok0 * 11008 + f8; const bf16_t* rm = r0 - (size_t)(okm ? 64 : 0) * 11008; const bf16_t* rp = r0 + (size_t)(okp ? 64 : 0) * 11008;
        float acc[3][8];
#pragma unroll
        for (int k = 0; k < 3; ++k)
#pragma unroll
            for (int e = 0; e < 8; ++e) acc[k][e] = bias[e];
        for (int xb = 0; xb < 64; xb += 4) {
            u32x4 am[4], a0[4], ap[4], vv[4];
#pragma unroll
            for (int c = 0; c < 4; ++c) { const size_t o = (size_t)(xb + c) * 11008;
                am[c] = okm ? *(const u32x4*)(rm + o) : (u32x4){0u, 0u, 0u, 0u}; a0[c] = *(const u32x4*)(r0 + o); ap[c] = okp ? *(const u32x4*)(rp + o) : (u32x4){0u, 0u, 0u, 0u};
                const int oc = xb + c - 1; vv[c] = *(const u32x4*)(r0 + (size_t)(oc < 0 ? 0 : oc) * 11008 + DFF); }
            u32x4 outw[4];
#pragma unroll
            for (int c = 0; c < 4; ++c) {
                const unsigned m4[4] = {am[c].x, am[c].y, am[c].z, am[c].w}, z4[4] = {a0[c].x, a0[c].y, a0[c].z, a0[c].w}, p4[4] = {ap[c].x, ap[c].y, ap[c].z, ap[c].w};
                unsigned plo[4], phi[4]; float sg[8];
#pragma unroll
                for (int fp = 0; fp < 4; ++fp) { plo[fp] = (m4[fp] & 0xffffu) | (z4[fp] << 16); phi[fp] = (m4[fp] >> 16) | (z4[fp] & 0xffff0000u); sg[2 * fp] = lo16(p4[fp]); sg[2 * fp + 1] = hi16(p4[fp]); }
#pragma unroll
                for (int dc = 0; dc < 3; ++dc) {
#pragma unroll
                    for (int fp = 0; fp < 4; ++fp) { acc[2 - dc][2 * fp] = dot2bf(plo[fp], wlo[dc][fp], acc[2 - dc][2 * fp]); acc[2 - dc][2 * fp + 1] = dot2bf(phi[fp], whi[dc][fp], acc[2 - dc][2 * fp + 1]); }
#pragma unroll
                    for (int e = 0; e < 8; ++e) acc[2 - dc][e] += sg[e] * ws[dc][e];
                }
                {
                    const u32x4 v = vv[c]; const float v8[8] = {lo16(v.x), hi16(v.x), lo16(v.y), hi16(v.y), lo16(v.z), hi16(v.z), lo16(v.w), hi16(v.w)}; float y[8];
#pragma unroll
                    for (int e = 0; e < 8; ++e) y[e] = gelu_tanh(acc[0][e]) * v8[e];
                    outw[c].x = pk2(y[0], y[1]); outw[c].y = pk2(y[2], y[3]); outw[c].z = pk2(y[4], y[5]); outw[c].w = pk2(y[6], y[7]);
                }
#pragma unroll
                for (int e = 0; e < 8; ++e) { acc[0][e] = acc[1][e]; acc[1][e] = acc[2][e]; acc[2][e] = bias[e]; }
            }
#pragma unroll
            for (int c = 0; c < 4; ++c) { const int oc = xb + c - 1; if (oc >= 0) *(u32x4*)(U + (tok0 + oc) * DFF + f8) = outw[c]; }
        }
        {
            const u32x4 v = *(const u32x4*)(r0 + (size_t)63 * 11008 + DFF); const float v8[8] = {lo16(v.x), hi16(v.x), lo16(v.y), hi16(v.y), lo16(v.z), hi16(v.z), lo16(v.w), hi16(v.w)}; float y[8];
#pragma unroll
            for (int e = 0; e < 8; ++e) y[e] = gelu_tanh(acc[0][e]) * v8[e];
            u32x4 o; o.x = pk2(y[0], y[1]); o.y = pk2(y[2], y[3]); o.z = pk2(y[4], y[5]); o.w = pk2(y[6], y[7]);
            *(u32x4*)(U + (tok0 + 63) * DFF + f8) = o;
        }
    }
}
constexpr int LDS_BYTES = 131072 + 64, NPHASE = 15;
#ifndef REP_IN
#define REP_IN 1
#endif
#ifndef REP0
#define REP0 1
#endif
#ifndef REP4
#define REP4 1
#endif
#ifndef REP6
#define REP6 1
#endif
#ifndef REP12
#define REP12 1
#endif
#ifndef REP9
#define REP9 1
#endif
#ifndef REPN
#define REPN 1
#endif
#ifndef XSYNC
#define XSYNC 0
#endif
#ifndef REP_SCAN
#define REP_SCAN 1
#endif

#define XB_TMO      128
#define XB_XSUB(j)  (1280 + 64 * (j))
#define XB_XGEN(j)  (2304 + 64 * (j))
#define XB_TOP      3328
#define XB_TOPGEN   3392
#define XB_CENS(s_, j) (3456 + 64 * (16 * (s_) + (j)))
#define XB_FLAT     5568
#define XB_PANEL(j) (5632 + 64 * (j))
#define XB_PANEL2(j) (5632 + 64 * 32 + 64 * (j))
#define XB_WORDS    (5632 + 64 * 64)
#define XB_SPIN_CAP (1u << 18)
__device__ unsigned g_xb[XB_WORDS];
DI unsigned xb_ld(unsigned* p)              { return __hip_atomic_load(p, __ATOMIC_RELAXED, __HIP_MEMORY_SCOPE_AGENT); }
DI void     xb_st(unsigned* p, unsigned v)  { __hip_atomic_store(p, v, __ATOMIC_RELAXED, __HIP_MEMORY_SCOPE_AGENT); }
DI unsigned xb_add(unsigned* p, unsigned v) { return __hip_atomic_fetch_add(p, v, __ATOMIC_RELAXED, __HIP_MEMORY_SCOPE_AGENT); }
DI unsigned xb_xcc_id() { return (unsigned)__builtin_amdgcn_s_getreg((3 << 11) | 20) & 0xFu; }
#define XB_SPIN(cond, bar) do { unsigned _sp = 0; while (cond) { __builtin_amdgcn_s_sleep(1); \
    if ((++_sp & 255u) == 0u) { if (xb_ld(&(bar)[XB_TMO])) break; if (_sp > XB_SPIN_CAP) { atomicAdd(&(bar)[XB_TMO], 1u); break; } } } } while (0)
DI void xb_post(volatile LAS unsigned* st) {
    asm volatile("s_waitcnt vmcnt(0)" ::: "memory");
    __syncthreads();
    if (threadIdx.x == 0) {
        unsigned* bar = g_xb; const unsigned G = gridDim.x;
        const unsigned set = (xb_ld(&bar[XB_FLAT]) / G) & 1u, x = xb_xcc_id();
        if (blockIdx.x == 0) {
            for (unsigned j = 0; j < 16; ++j) { xb_st(&bar[XB_CENS(set ^ 1u, j)], 0u); xb_st(&bar[XB_XSUB(j)], 0u); xb_st(&bar[XB_XGEN(j)], 0u); }
            xb_st(&bar[XB_TOP], 0u); xb_st(&bar[XB_TOPGEN], 0u); xb_st(&bar[XB_TMO], 0u);
            for (unsigned j = 0; j < 32; ++j) { xb_st(&bar[XB_PANEL(j)], 0u); xb_st(&bar[XB_PANEL2(j)], 0u); }
        }
        xb_add(&bar[XB_CENS(set, x)], 1u);
        __builtin_amdgcn_fence(__ATOMIC_RELEASE, "agent");
        asm volatile("s_waitcnt vmcnt(0)" ::: "memory");
        const unsigned old = xb_add(&bar[XB_FLAT], 1u);
        st[2] = x; st[3] = (old / G + 1u) * G; st[4] = set;
    }
}
DI void xb_wait(volatile LAS unsigned* st) {
    if (threadIdx.x == 0) {
        unsigned* bar = g_xb; const unsigned target = st[3], set = st[4], x = st[2];
        while ((int)(xb_ld(&bar[XB_FLAT]) - target) < 0) __builtin_amdgcn_s_sleep(1);
        __builtin_amdgcn_fence(__ATOMIC_ACQUIRE, "agent");
        asm volatile("s_waitcnt vmcnt(0)" ::: "memory");
        unsigned nloc = 1u, nx = 0u;
        for (unsigned j = 0; j < 16; ++j) { const unsigned c = xb_ld(&bar[XB_CENS(set, j)]); nx += (c > 0u) ? 1u : 0u; nloc = (j == x) ? c : nloc; }
        st[0] = nloc > 0u ? nloc : 1u; st[1] = nx > 0u ? nx : 1u;
    }
    __syncthreads();
}
DI void grid_bar(volatile LAS unsigned* st) {
    asm volatile("s_waitcnt vmcnt(0)" ::: "memory");
    __syncthreads();
    if (threadIdx.x == 0) {
        unsigned* bar = g_xb;
        __builtin_amdgcn_s_waitcnt(0);
        const unsigned nloc = st[0], nx = st[1], x = st[2];
        const unsigned old = xb_add(&bar[XB_XSUB(x)], 1u);
        const unsigned gen = old / nloc;
        if (old + 1u == (gen + 1u) * nloc) {
            __builtin_amdgcn_fence(__ATOMIC_RELEASE, "agent");
            asm volatile("s_waitcnt vmcnt(0)" ::: "memory");
            const unsigned og = xb_add(&bar[XB_TOP], 1u);
            const unsigned tg = og / nx;
            if (og + 1u == (tg + 1u) * nx) xb_add(&bar[XB_TOPGEN], 1u);
            else XB_SPIN(xb_ld(&bar[XB_TOPGEN]) == tg, bar);
            __builtin_amdgcn_fence(__ATOMIC_ACQUIRE, "agent");
            xb_add(&bar[XB_XGEN(x)], 1u);
            asm volatile("s_waitcnt vmcnt(0)" ::: "memory");
        } else {
            XB_SPIN(xb_ld(&bar[XB_XGEN(x)]) == gen, bar);
            __builtin_amdgcn_fence(__ATOMIC_ACQUIRE, "agent");
            asm volatile("s_waitcnt vmcnt(0)" ::: "memory");
        }
    }
    __syncthreads();
}

__global__ void __launch_bounds__(512, 2) fwd_megakernel(Params p, int ph_lo, int ph_hi) {
    extern __shared__ __attribute__((aligned(16))) unsigned char shm[];
    LAS unsigned char* lds = (LAS unsigned char*)shm;
    cg::grid_group grid = cg::this_grid();
    volatile LAS unsigned* bst = (volatile LAS unsigned*)(lds + 131072);
    unsigned char* ws = p.ws;
    const float* mod = (const float*)(ws + W_MOD);
#define PHASE(k) if ((k) > ph_lo && (k) < ph_hi) { if (ph_hi > 1000) grid.sync(); else grid_bar(bst); } if ((k) >= ph_lo && (k) < ph_hi)
    {
        {
        PHASE(0) {
            ada_phase(p, lds);
            xb_post(bst);
            convert_T<256>(p.w_in, DM, NIN, (bf16_t*)(ws + W_INT), NINP, MapIn(), lds, blockIdx.x, gridDim.x);
            convert_T<256>(p.w_rp, DM, DM, (bf16_t*)(ws + W_RPT), DM, MapPlain(), lds, blockIdx.x, gridDim.x);
            convert_T<256>(p.w_gp, DM, DM, (bf16_t*)(ws + W_GPT), DM, MapPlain(), lds, blockIdx.x, gridDim.x);
            convert_T<256>(p.w_o, DM, DM, (bf16_t*)(ws + W_OT), DM, MapPlain(), lds, blockIdx.x, gridDim.x);
            rope_table(p);
            xb_wait(bst);
            norm_phase<0>(p, TROWS, p.x, p.ctx, p.norm1_g, 0, DM, (bf16_t*)(ws + W_H), nullptr);
        }
        PHASE(3) { { pg8::Gemm g; g.A = (const bf16_t*)(ws + W_H); g.Bt = (const bf16_t*)(ws + W_INT); g.M = TROWS; g.N = NINP; g.K = DM;
                  SchedIn S; S.init(gridDim.x, blockIdx.x); EpiIn E; E.ws = ws;
                  for (int rep = 0; rep < REP_IN; ++rep) pg8::gemm_phase<EpiIn, SchedIn, false>(lds, g, S, E, nullptr);
                  const int G = gridDim.x, U = 32 * 73 + 4 * 29, busy = U - ((U - 1) / G) * G, c = blockIdx.x;
                  if (busy < G) { if (c >= busy) convert_T<256>(p.w_up, DM, 2 * DFF, (bf16_t*)(ws + W_UPT), 2 * DFF, MapPlain(), lds, c - busy, G - busy); }
                  else convert_T<256>(p.w_up, DM, 2 * DFF, (bf16_t*)(ws + W_UPT), 2 * DFF, MapPlain(), lds, c, G); } }
        PHASE(4) {
            for (int rep = 0; rep < REP4; ++rep) prep_gla(p, lds);
            }
        PHASE(5) { for (int rep = 0; rep < REP_SCAN; ++rep) scan_phase(p, lds); }
        PHASE(6) { for (int rep = 0; rep < REP6; ++rep) {
            readout_phase(p);
            } }
        PHASE(7) {
            if (256 % gridDim.x == 0) {
                pg8::Gemm g; g.A = (const bf16_t*)(ws + W_R); g.Bt = (const bf16_t*)(ws + W_RPT); g.M = 2 * LROWS; g.N = 2 * DM; g.K = DM;
                SchedRG S; S.init(gridDim.x, blockIdx.x); EpiRG E; E.ws = ws;
                pg8::gemm_phase<EpiRG, SchedRG, false>(lds, g, S, E, nullptr);
            } else {
                { EpiB<1> E; E.O = (bf16_t*)(ws + W_T); E.ld = DM; E.g1 = (const bf16_t*)(ws + W_MR); E.add = nullptr;
                  run_gemm(lds, (const bf16_t*)(ws + W_R), (const bf16_t*)(ws + W_RPT), LROWS, DM, DM, E); }
                grid_bar(bst);
                { EpiB<2> E; E.O = (bf16_t*)(ws + W_Z); E.ld = DM; E.g1 = (const bf16_t*)(ws + W_MG); E.add = (const bf16_t*)(ws + W_T);
                  run_gemm(lds, (const bf16_t*)(ws + W_G), (const bf16_t*)(ws + W_GPT), LROWS, DM, DM, E); }
            }
        }
        PHASE(9) {
            if (gridDim.x == 256) {
                EpiResNorm<1> E; E.base = p.x; E.out = p.out; E.mod = mod; E.b_ada = p.b_ada; E.goff = 2 * DM; E.fg = p.norm2_g; E.ssq = (float*)(ws + W_SSQ + 256 * 1024); E.cnt = g_xb + XB_PANEL2(0);
                E.hb = (bf16_t*)(ws + W_H2); E.sh_off = 3 * DM; E.sc_off = 4 * DM;
                run_gemm(lds, (const bf16_t*)(ws + W_Z), (const bf16_t*)(ws + W_OT), LROWS, DM, DM, E);
            } else {
                { EpiRes E; E.base = p.x; E.out = p.out; E.mod = mod; E.b_ada = p.b_ada; E.goff = 2 * DM;
                  run_gemm(lds, (const bf16_t*)(ws + W_Z), (const bf16_t*)(ws + W_OT), LROWS, DM, DM, E); }
                grid_bar(bst);
                norm_phase<0>(p, LROWS, p.out, p.out, p.norm2_g, 3 * DM, 4 * DM, (bf16_t*)(ws + W_H2), nullptr);
            }
        }
        PHASE(11) { { EpiB<0> E; E.O = (bf16_t*)(ws + W_AV); E.ld = 2 * DFF; E.g1 = nullptr; E.add = nullptr;
                   run_gemm(lds, (const bf16_t*)(ws + W_H2), (const bf16_t*)(ws + W_UPT), LROWS, 2 * DFF, DM, E);
                   const int G = gridDim.x, U = 32 * 43, busy = U - ((U - 1) / G) * G, c = blockIdx.x;
                   if (busy < G) { if (c >= busy) convert_T<128>(p.w_down, DFF, DM, (bf16_t*)(ws + W_DNT), DM, MapPlain(), lds, c - busy, G - busy); }
                   else convert_T<128>(p.w_down, DFF, DM, (bf16_t*)(ws + W_DNT), DM, MapPlain(), lds, c, G); } }
        PHASE(12) { for (int rep = 0; rep < REP12; ++rep) conv_phase(p); }
        PHASE(13) {
            if (gridDim.x == 256) {
                EpiResNorm<0> E; E.base = p.out; E.out = p.out; E.mod = mod; E.b_ada = p.b_ada; E.goff = 5 * DM; E.fg = p.final_g; E.ssq = (float*)(ws + W_SSQ); E.cnt = g_xb + XB_PANEL(0); E.hb = nullptr; E.sh_off = 0; E.sc_off = 0;
                run_gemm(lds, (const bf16_t*)(ws + W_U), (const bf16_t*)(ws + W_DNT), LROWS, DM, DFF, E);
            } else {
                EpiRes E; E.base = p.out; E.out = p.out; E.mod = mod; E.b_ada = p.b_ada; E.goff = 5 * DM;
                run_gemm(lds, (const bf16_t*)(ws + W_U), (const bf16_t*)(ws + W_DNT), LROWS, DM, DFF, E);
                grid_bar(bst);
                norm_phase<1>(p, LROWS, p.out, p.out, p.final_g, 0, 0, nullptr, p.out);
            }
        }
        }
    }
}


#ifndef CUT
#define CUT -1
#endif
__global__ void dump_kernel(Params p) {
    const unsigned short* w = (const unsigned short*)p.ws; const size_t n = W_END / 2, N = (size_t)LROWS * DM;
    for (size_t i = (size_t)blockIdx.x * 256 + threadIdx.x; i < N; i += (size_t)gridDim.x * 256) {
        float s = 0.f; for (size_t j = i; j < n; j += N) { const float v = bf2f(w[j]); s += (v == v && fabsf(v) < 1e30f) ? v : 1000.f; }
        p.out[i] = s;
    }
}
extern "C" void kernel_launch(void* const* d_in, const int* in_sizes, int n_in, void* d_out, int out_size, void* d_ws, size_t ws_size, hipStream_t stream) {
    static int grid = 0;
    if (grid == 0) {
        if (n_in != 22 || ws_size < W_END) { fprintf(stderr, "kernel_launch: unexpected inputs (n_in %d, ws %zu, need %zu)\n", n_in, ws_size, (size_t)W_END); grid = -1; return; }
        int dev = 0, cus = 0, per_cu = 0;
        (void)hipGetDevice(&dev); (void)hipDeviceGetAttribute(&cus, hipDeviceAttributeMultiprocessorCount, dev);
        if (hipFuncSetAttribute((const void*)fwd_megakernel, hipFuncAttributeMaxDynamicSharedMemorySize, LDS_BYTES) != hipSuccess) { fprintf(stderr, "hipFuncSetAttribute failed\n"); grid = -1; return; }
        if (hipOccupancyMaxActiveBlocksPerMultiprocessor(&per_cu, (const void*)fwd_megakernel, 512, LDS_BYTES) != hipSuccess || per_cu < 1) { fprintf(stderr, "occupancy query failed (%d)\n", per_cu); per_cu = 1; (void)hipGetLastError(); }
        grid = cus * per_cu;
        if (grid > 256) grid = 256;
    }
    if (grid < 0) return;
    Params p{};
    const float** pp = (const float**)&p;
    for (int i = 0; i < 22; ++i) pp[i] = (const float*)d_in[i];
    p.out = (float*)d_out; p.ws = (unsigned char*)d_ws;
#ifndef NLAUNCH
#define NLAUNCH 1
#endif
    for (int li = 0; li < NLAUNCH; ++li) {
        int lo = NLAUNCH == 1 ? 0 : li, hi = NLAUNCH == 1 ? (CUT >= 0 ? CUT + 1 : NPHASE) : li + 1;
        void* args[] = {&p, &lo, &hi};
        hipError_t e = hipLaunchCooperativeKernel((const void*)fwd_megakernel, dim3(grid), dim3(512), args, LDS_BYTES, stream);
        if (e != hipSuccess) { fprintf(stderr, "cooperative launch failed: %s (grid %d)\n", hipGetErrorString(e), grid); break; }
    }
    if (CUT >= 0) hipLaunchKernelGGL(dump_kernel, dim3(2048), dim3(256), 0, stream, p);
}
```
